# Optimizing an MI355X kernel written in HIP

```python
import math
import jax, jax.numpy as jnp
from jax import lax
import numpy as np

D_MODEL = 1024
BATCH = 8
SEQ = 4096
DEPTH = 2

CHUNK = 64
Q_BLOCK = 128
POOL_WINDOWS = (2, 4, 8, 16)
N_POOL_GROUPS = len(POOL_WINDOWS)
POOL_GROUP_DIM = D_MODEL // 8
POOL_DIM = N_POOL_GROUPS * POOL_GROUP_DIM
N_HEADS = 8
HEAD_DIM = D_MODEL // 16
V_HEAD_DIM = 2 * HEAD_DIM
QK_DIM = N_HEADS * 2 * HEAD_DIM
V_DIM = N_HEADS * V_HEAD_DIM
IN_DIM = POOL_DIM + 2 * QK_DIM + V_DIM
D_FF = 4 * D_MODEL
N_BRANCHES = 2
EPS = 1e-6

kernel_name = "hybrid_pool_diffattn_gated_encoder"


def rmsnorm(x, g):
    xf = x.astype(jnp.float32)
    y = xf * lax.rsqrt(jnp.mean(xf * xf, axis=-1, keepdims=True) + EPS)
    return (y * g.astype(jnp.float32)).astype(x.dtype)


def head_rmsnorm(x, g):
    xf = x.astype(jnp.float32)
    return xf * lax.rsqrt(jnp.mean(xf * xf, axis=-1, keepdims=True) + EPS) * g.astype(jnp.float32)


def alibi_slopes(n):
    return jnp.asarray(np.array([2.0 ** (-8.0 * (i + 1) / n) for i in range(n)], dtype=np.float32))


def pool_mixer(u, w_grp, scale):
    B, S, _ = u.shape
    uf = u.astype(jnp.float32).reshape(B, S, N_POOL_GROUPS, POOL_GROUP_DIM)
    csum = jnp.pad(jnp.cumsum(uf, axis=1), ((0, 0), (1, 0), (0, 0), (0, 0)))
    t = jnp.arange(S)
    pooled = []
    for g, w in enumerate(POOL_WINDOWS):
        lo = jnp.maximum(t + 1 - w, 0)
        win_sum = csum[:, 1:, g] - csum[:, lo, g]
        cnt = (t + 1 - lo).astype(jnp.float32)
        pooled.append(win_sum / cnt[None, :, None])
    mixed = jnp.stack(pooled, axis=2) - uf
    y = jnp.einsum('bsgc,gcd->bsgd', mixed, w_grp.astype(jnp.float32))
    return (y.reshape(B, S, POOL_DIM) * scale.astype(jnp.float32)).astype(u.dtype)


def diff_attention(q, k, v, g_q, g_k, lam, g_sub, lambda_init):
    B, S = q.shape[0], q.shape[1]
    qn = head_rmsnorm(q, g_q) * (HEAD_DIM ** -0.5)
    kn = head_rmsnorm(k, g_k)
    vf = v.astype(jnp.float32)
    lam = lam.astype(jnp.float32)
    slopes = alibi_slopes(N_HEADS)
    pos = jnp.arange(S)
    key_chunk = pos // CHUNK
    nb = S // Q_BLOCK
    q_blocks = qn.reshape(B, nb, Q_BLOCK, N_HEADS, 2, HEAD_DIM).transpose(1, 0, 2, 3, 4, 5)
    q_pos = pos.reshape(nb, Q_BLOCK)
    neg = jnp.finfo(jnp.float32).min

    def block(args):
        qblk, qp = args
        s = jnp.einsum('bqhid,bkhid->bihqk', qblk, kn)
        dist = jnp.abs(qp[:, None] - pos[None, :]).astype(jnp.float32)
        bias = -slopes[:, None, None] * dist
        allowed = key_chunk[None, :] <= (qp // CHUNK)[:, None]
        s = jnp.where(allowed, s + bias, neg)
        p = jax.nn.softmax(s, axis=-1)
        a = p[:, 0] - lam * p[:, 1]
        return jnp.einsum('bhqk,bkhe->bqhe', a, vf)

    o = lax.map(block, (q_blocks, q_pos))
    o = o.transpose(1, 0, 2, 3, 4).reshape(B, S, N_HEADS, V_HEAD_DIM)
    o = head_rmsnorm(o, g_sub) * (1.0 - lambda_init)
    return o.reshape(B, S, V_DIM).astype(v.dtype)


def setup_inputs(seed: int = 0) -> dict:
    key = jax.random.key(seed)
    ks = jax.random.split(key, 20)
    f32 = jnp.float32

    def nrm(k, shape, fan_in):
        return jax.random.normal(k, shape, f32) * (fan_in ** -0.5)

    def gain(k, shape):
        return 1.0 + 0.05 * jax.random.normal(k, shape, f32)

    return {
        "x": jax.random.normal(ks[0], (BATCH, SEQ, D_MODEL), f32),
        "g_mix": gain(ks[1], (DEPTH, D_MODEL)),
        "w_in": nrm(ks[2], (DEPTH, D_MODEL, IN_DIM), D_MODEL),
        "w_pool_grp": nrm(ks[3], (DEPTH, N_POOL_GROUPS, POOL_GROUP_DIM, POOL_GROUP_DIM), POOL_GROUP_DIM),
        "pool_scale": gain(ks[4], (DEPTH, POOL_DIM)),
        "g_q": gain(ks[5], (DEPTH, HEAD_DIM)),
        "g_k": gain(ks[6], (DEPTH, HEAD_DIM)),
        "lambda_qk": 0.1 * jax.random.normal(ks[7], (DEPTH, 4, HEAD_DIM), f32),
        "g_sub": gain(ks[8], (DEPTH, V_HEAD_DIM)),
        "w_branch_pool": nrm(ks[9], (DEPTH, POOL_DIM, D_MODEL), POOL_DIM),
        "w_branch_attn": nrm(ks[10], (DEPTH, V_DIM, D_MODEL), V_DIM),
        "w_gate": nrm(ks[11], (DEPTH, D_MODEL, N_BRANCHES * D_MODEL), D_MODEL),
        "b_gate": 0.01 * jax.random.normal(ks[12], (DEPTH, N_BRANCHES * D_MODEL), f32),
        "w_out": nrm(ks[13], (DEPTH, D_MODEL, D_MODEL), D_MODEL),
        "g_ffn": gain(ks[14], (DEPTH, D_MODEL)),
        "w_up": nrm(ks[15], (DEPTH, D_MODEL, D_FF), D_MODEL),
        "w_down": nrm(ks[16], (DEPTH, D_FF, D_MODEL), D_FF),
    }


def reference(x, g_mix, w_in, w_pool_grp, pool_scale, g_q, g_k, lambda_qk, g_sub,
              w_branch_pool, w_branch_attn, w_gate, b_gate, w_out, g_ffn, w_up, w_down):
    B, S, _ = x.shape
    for l in range(DEPTH):
        lambda_init = 0.8 - 0.6 * math.exp(-0.3 * l)
        h = rmsnorm(x, g_mix[l])
        z = h @ w_in[l]
        u_pool = z[..., :POOL_DIM]
        q = z[..., POOL_DIM:POOL_DIM + QK_DIM].reshape(B, S, N_HEADS, 2, HEAD_DIM)
        k = z[..., POOL_DIM + QK_DIM:POOL_DIM + 2 * QK_DIM].reshape(B, S, N_HEADS, 2, HEAD_DIM)
        v = z[..., POOL_DIM + 2 * QK_DIM:].reshape(B, S, N_HEADS, V_HEAD_DIM)

        y_pool = pool_mixer(u_pool, w_pool_grp[l], pool_scale[l])
        lq = lambda_qk[l].astype(jnp.float32)
        lam = jnp.exp(jnp.sum(lq[0] * lq[1])) - jnp.exp(jnp.sum(lq[2] * lq[3])) + lambda_init
        y_attn = diff_attention(q, k, v, g_q[l], g_k[l], lam, g_sub[l], lambda_init)

        gates = jax.nn.sigmoid(h @ w_gate[l] + b_gate[l])
        merged = (gates[..., :D_MODEL] * (y_pool @ w_branch_pool[l])
                  + gates[..., D_MODEL:] * (y_attn @ w_branch_attn[l]))
        x = x + merged @ w_out[l]

        h2 = rmsnorm(x, g_ffn[l])
        x = x + jnp.square(jax.nn.relu(h2 @ w_up[l])) @ w_down[l]
    return x
```

```cpp
#include <hip/hip_runtime.h>
#include <hip/hip_cooperative_groups.h>
#include <cstdio>
#include <cstdint>
namespace cg = cooperative_groups;
namespace pg8 {
#define PG8_LAS __attribute__((address_space(3)))
typedef unsigned short bf16_t;
typedef short bf16x8 __attribute__((ext_vector_type(8)));
typedef float f32x4 __attribute__((ext_vector_type(4)));
typedef unsigned u32x4 __attribute__((ext_vector_type(4)));
constexpr int BM = 256, BK = 64, HALF = 128, HTB = HALF * BK * 2  , STAGE_BYTES = 8 * HTB, NXCD = 8, WGM = 8;

__host__ __device__ __forceinline__ int lds_byte(int r, int c) { const int st = (r >> 4) * 2 + (c >> 5), rr = r & 15, cc = c & 31, ob = rr * 64 + cc * 2; return st * 1024 + (ob ^ (((ob >> 9) & 1) << 5)); }
__host__ __device__ __forceinline__ void stage_rc(int b, int& R, int& C) { const int st = b / 1024, sb = b % 1024, swz = sb ^ (((sb >> 9) & 1) << 5); R = (st >> 1) * 16 + swz / 64; C = (st & 1) * 32 + (swz % 64) / 2; }
__host__ __device__ __forceinline__ int perm32(int rho) { const int n = rho >> 4, i = rho & 15; return 8 * (i >> 2) + 4 * n + (i & 3); }

struct Unit { int pm, pn; };
struct Gemm { const bf16_t* A; const bf16_t* Bt; int M, N, K; int N_seg0K = 0; };

struct StaticOrder {
    int nM, nN, nwg, G, c;
    __host__ __device__ void init(int M, int N, int G_, int c_) { nM = M / BM; nN = N / BM; nwg = nM * nN; G = G_; c = c_; }
    __host__ __device__ bool next(int i, Unit& u) const {
        const long L = (long)i * G + c; if (L >= nwg) return false;
        int wgid = (int)L; { const int q = nwg / NXCD, r = nwg % NXCD, xcd = wgid % NXCD, off = wgid / NXCD; wgid = (xcd < r ? xcd * (q + 1) : r * (q + 1) + (xcd - r) * q) + off; }
        const int nig = WGM * nN, gid = wgid / nig, fm = gid * WGM, gsz = (nM - fm) < WGM ? (nM - fm) : WGM;
        u.pm = fm + ((wgid % nig) % gsz); u.pn = (wgid % nig) / gsz; return true;
    }
    __device__ __forceinline__ void a_ready(const Unit&) const {}
    __device__ __forceinline__ void done(const Unit&) const {}
};
__device__ __forceinline__ unsigned cvt_pk_bf16(float lo, float hi) { unsigned r; asm volatile("v_cvt_pk_bf16_f32 %0, %1, %2" : "=v"(r) : "v"(lo), "v"(hi)); return r; }
typedef float f32x2 __attribute__((ext_vector_type(2)));
template <class Epi, class Sched, bool ALIGN_EPI = false, bool SP2 = false>
__device__ __forceinline__ void gemm_phase(PG8_LAS unsigned char* lds, const Gemm g, const Sched& S, const Epi& E) {
    int tid_ = threadIdx.x; asm volatile("" : "+v"(tid_));
    const int tid = tid_, wid = __builtin_amdgcn_readfirstlane(tid >> 6), lane = tid & 63, wr = wid >> 2, wc = wid & 3, fr = lane & 15, fq = lane >> 4;
    const int K = g.K, nt = K / BK;
    unsigned voffA[2], voffB[2];
#pragma unroll
    for (int i = 0; i < 2; ++i) { int R, C; stage_rc(tid * 16 + i * 8192, R, C); const int Rb = Epi::PERM ? ((R & ~31) + perm32(R & 31)) : R;
        voffA[i] = (unsigned)(R * K + C) * 2u; voffB[i] = (unsigned)(Rb * K + C) * 2u; }
    const size_t kstep = (size_t)(BK * 2);
    const size_t hstep = (size_t)HALF * K * 2;
    const size_t tstep = 2 * hstep;
    const unsigned ldsw = (unsigned)wid * 1024u;
    const int aoff = lds_byte(wr * 64 + fr, fq * 8), boff = lds_byte(wc * 32 + fr, fq * 8);
#define PG8_SA(b, h) (((b) * 2 + (h)) * HTB)
#define PG8_SB(b, h) ((4 + (b) * 2 + (h)) * HTB)
#define PG8_STAGE(bufoff, gbase, voff) do { _Pragma("unroll") for (int _i = 0; _i < 2; ++_i) \
        __builtin_amdgcn_global_load_lds((const unsigned*)((const char*)(gbase) + (voff)[_i]), (PG8_LAS unsigned*)(lds + (bufoff) + ldsw + _i * 8192), 16, 0, 0); } while (0)
#define PG8_LDA(dst, b, h) do { _Pragma("unroll") for (int m = 0; m < 4; ++m) _Pragma("unroll") for (int k = 0; k < 2; ++k) dst[m][k] = *(const PG8_LAS bf16x8*)(lds + PG8_SA(b, h) + aoff + m * 2048 + k * 1024); } while (0)
#define PG8_LDB(dst, b, h) do { _Pragma("unroll") for (int n = 0; n < 2; ++n) _Pragma("unroll") for (int k = 0; k < 2; ++k) dst[n][k] = *(const PG8_LAS bf16x8*)(lds + PG8_SB(b, h) + boff + n * 2048 + k * 1024); } while (0)
#define PG8_MMA(ai, bj, At, Bt) do { __builtin_amdgcn_s_setprio(1); _Pragma("unroll") for (int m = 0; m < 4; ++m) _Pragma("unroll") for (int n = 0; n < 2; ++n) _Pragma("unroll") for (int k = 0; k < 2; ++k) \
        acc[ai][bj][m][n] = __builtin_amdgcn_mfma_f32_16x16x32_bf16(Bt[n][k], At[m][k], acc[ai][bj][m][n], 0, 0, 0); __builtin_amdgcn_s_setprio(0); } while (0)
#define PG8_WAIT_V(n) asm volatile("s_waitcnt vmcnt(" #n ")" ::: "memory")
#define PG8_WAIT_L(n) asm volatile("s_waitcnt lgkmcnt(" #n ")" ::: "memory")
#define PG8_BAR __builtin_amdgcn_s_barrier()
#define PG8_SCHED __builtin_amdgcn_sched_barrier(0)
    Unit cur, nxt; int ui = 0;
    if (!S.next(0, cur)) return;
    f32x4 acc[2][2][4][2];
#pragma unroll
    for (int a = 0; a < 2; ++a)
#pragma unroll
        for (int b = 0; b < 2; ++b)
#pragma unroll
            for (int m = 0; m < 4; ++m)
#pragma unroll
                for (int n = 0; n < 2; ++n) acc[a][b][m][n] = (f32x4){0.f, 0.f, 0.f, 0.f};
    bf16x8 At[4][2], B0[2][2], B1[2][2];
    const char* cA = (const char*)g.A + (size_t)cur.pm * tstep; const char* cB = (const char*)g.Bt + (size_t)cur.pn * tstep;
    S.a_ready(cur);
    if constexpr (SP2) {
        PG8_STAGE(PG8_SB(0, 0), cB, voffB); PG8_STAGE(PG8_SB(0, 1), cB + hstep, voffB); PG8_STAGE(PG8_SA(0, 0), cA, voffA); PG8_STAGE(PG8_SA(0, 1), cA + hstep, voffA);
        if (wr == 1) PG8_BAR;
        PG8_WAIT_V(2); PG8_BAR;
        PG8_STAGE(PG8_SB(1, 0), cB + kstep, voffB); PG8_STAGE(PG8_SA(1, 0), cA + kstep, voffA); PG8_STAGE(PG8_SB(1, 1), cB + hstep + kstep, voffB);
        PG8_WAIT_V(6); PG8_BAR;
    } else {
        PG8_STAGE(PG8_SB(0, 0), cB, voffB); PG8_STAGE(PG8_SA(0, 0), cA, voffA); PG8_STAGE(PG8_SB(0, 1), cB + hstep, voffB); PG8_STAGE(PG8_SA(0, 1), cA + hstep, voffA);
        if (wr == 1) PG8_BAR;
        PG8_WAIT_V(4); PG8_BAR;
        PG8_STAGE(PG8_SB(1, 0), cB + kstep, voffB); PG8_STAGE(PG8_SA(1, 0), cA + kstep, voffA); PG8_STAGE(PG8_SB(1, 1), cB + hstep + kstep, voffB);
        PG8_WAIT_V(6); PG8_BAR;
    }
    for (;;) {
        const bool has_next = S.next(ui + 1, nxt);
        const char* nA = has_next ? (const char*)g.A + (size_t)nxt.pm * tstep : cA; const char* nB = has_next ? (const char*)g.Bt + (size_t)nxt.pn * tstep : cB;
        for (int t = 0; t < nt; t += 2) {
            const bool last = (t == nt - 2);
            const char* a1 = cA + (size_t)(t + 1) * kstep;
            const char* a2 = last ? nA : cA + (size_t)(t + 2) * kstep; const char* b2 = last ? nB : cB + (size_t)(t + 2) * kstep;
            const char* a3 = a2 + kstep; const char* b3 = b2 + kstep;
            if (last && has_next) S.a_ready(nxt);
            if constexpr (SP2) {
            PG8_LDB(B0, 0, 0); PG8_LDB(B1, 0, 1); PG8_SCHED; PG8_LDA(At, 0, 0); PG8_STAGE(PG8_SA(1, 1), a1 + hstep, voffA);
            PG8_WAIT_V(8); PG8_WAIT_L(0); PG8_BAR; PG8_MMA(0, 0, At, B0); PG8_MMA(0, 1, At, B1); PG8_BAR; PG8_SCHED;
            PG8_LDA(At, 0, 1); PG8_STAGE(PG8_SB(0, 0), b2, voffB); PG8_STAGE(PG8_SB(0, 1), b2 + hstep, voffB); PG8_STAGE(PG8_SA(0, 0), a2, voffA);
            PG8_WAIT_V(8); PG8_WAIT_L(0); PG8_BAR; PG8_MMA(1, 0, At, B0); PG8_MMA(1, 1, At, B1); PG8_BAR; PG8_SCHED;
            PG8_LDB(B0, 1, 0); PG8_LDB(B1, 1, 1); PG8_SCHED; PG8_LDA(At, 1, 0); PG8_STAGE(PG8_SA(0, 1), a2 + hstep, voffA);
            PG8_WAIT_V(8); PG8_WAIT_L(0); PG8_BAR; PG8_MMA(0, 0, At, B0); PG8_MMA(0, 1, At, B1); PG8_BAR; PG8_SCHED;
            PG8_LDA(At, 1, 1); PG8_STAGE(PG8_SB(1, 0), b3, voffB); PG8_STAGE(PG8_SB(1, 1), b3 + hstep, voffB); PG8_STAGE(PG8_SA(1, 0), a3, voffA);
            PG8_WAIT_V(8); PG8_WAIT_L(0); PG8_BAR; PG8_MMA(1, 0, At, B0); PG8_MMA(1, 1, At, B1); PG8_BAR; PG8_SCHED;
            } else {
            PG8_LDB(B0, 0, 0); PG8_SCHED; PG8_LDA(At, 0, 0); PG8_STAGE(PG8_SA(1, 1), a1 + hstep, voffA);
            PG8_WAIT_L(8); PG8_BAR; PG8_WAIT_L(0); PG8_MMA(0, 0, At, B0); PG8_BAR; PG8_SCHED;
            PG8_LDB(B1, 0, 1); PG8_STAGE(PG8_SB(0, 0), b2, voffB);
            PG8_BAR; PG8_WAIT_L(0); PG8_MMA(0, 1, At, B1); PG8_BAR;
            PG8_LDA(At, 0, 1); PG8_STAGE(PG8_SA(0, 0), a2, voffA);
            PG8_BAR; PG8_WAIT_L(0); PG8_MMA(1, 0, At, B0); PG8_BAR; PG8_SCHED;
            PG8_STAGE(PG8_SB(0, 1), b2 + hstep, voffB);
            PG8_WAIT_V(6); PG8_BAR; PG8_MMA(1, 1, At, B1); PG8_BAR;
            PG8_LDB(B0, 1, 0); PG8_SCHED; PG8_LDA(At, 1, 0); PG8_STAGE(PG8_SA(0, 1), a2 + hstep, voffA);
            PG8_WAIT_L(8); PG8_BAR; PG8_WAIT_L(0); PG8_MMA(0, 0, At, B0); PG8_BAR; PG8_SCHED;
            PG8_LDB(B1, 1, 1); PG8_STAGE(PG8_SB(1, 0), b3, voffB);
            PG8_BAR; PG8_WAIT_L(0); PG8_MMA(0, 1, At, B1); PG8_BAR;
            PG8_LDA(At, 1, 1); PG8_STAGE(PG8_SA(1, 0), a3, voffA);
            PG8_BAR; PG8_WAIT_L(0); PG8_MMA(1, 0, At, B0); PG8_BAR; PG8_SCHED;
            PG8_STAGE(PG8_SB(1, 1), b3 + hstep, voffB);
            PG8_WAIT_V(6); PG8_BAR; PG8_MMA(1, 1, At, B1); PG8_BAR;
            }
        }
        if constexpr (ALIGN_EPI) { if (wr == 0) PG8_BAR; }
        if constexpr (!Epi::AFTER_DRAIN) { E(acc, cur, wr, wc, fr, fq); S.done(cur); }
        if (!has_next) break;
#pragma unroll
        for (int a = 0; a < 2; ++a)
#pragma unroll
            for (int b = 0; b < 2; ++b)
#pragma unroll
                for (int m = 0; m < 4; ++m)
#pragma unroll
                    for (int n = 0; n < 2; ++n) acc[a][b][m][n] = (f32x4){0.f, 0.f, 0.f, 0.f};
        cur = nxt; cA = nA; cB = nB; ++ui;
        if constexpr (ALIGN_EPI) { if (wr == 1) PG8_BAR; }
    }
    PG8_WAIT_V(0);
    if constexpr (!ALIGN_EPI) { if (wr == 0) PG8_BAR; }
    PG8_BAR;
    if constexpr (Epi::AFTER_DRAIN) { E.fused(acc, cur, wr, wc, fr, fq, lds, wid, lane); S.done(cur); }
}
template <class Epi, class Sched, bool ALIGN_EPI = false, bool SP2 = false>
__device__ __forceinline__ void gemm_phase2(PG8_LAS unsigned char* lds, const Gemm g, const bf16_t* A1, const bf16_t* Bt1, int K1, const Sched& S, const Epi& E) {
    int tid_ = threadIdx.x; asm volatile("" : "+v"(tid_));
    const int tid = tid_, wid = __builtin_amdgcn_readfirstlane(tid >> 6), lane = tid & 63, wr = wid >> 2, wc = wid & 3, fr = lane & 15, fq = lane >> 4;
    const int K = g.K  , nt0 = g.N_seg0K / BK, nt1 = K1 / BK;
    unsigned voffA[2], voffB[2];
#pragma unroll
    for (int i = 0; i < 2; ++i) { int R, C; stage_rc(tid * 16 + i * 8192, R, C); const int Rb = Epi::PERM ? ((R & ~31) + perm32(R & 31)) : R;
        voffA[i] = (unsigned)(R * K + C) * 2u; voffB[i] = (unsigned)(Rb * K + C) * 2u; }
    const size_t kstep = (size_t)(BK * 2);
    const size_t hstep = (size_t)HALF * K * 2;
    const size_t tstep = 2 * hstep;
    const unsigned ldsw = (unsigned)wid * 1024u;
    const int aoff = lds_byte(wr * 64 + fr, fq * 8), boff = lds_byte(wc * 32 + fr, fq * 8);
#define PG8_SA(b, h) (((b) * 2 + (h)) * HTB)
#define PG8_SB(b, h) ((4 + (b) * 2 + (h)) * HTB)
#define PG8_STAGE(bufoff, gbase, voff) do { _Pragma("unroll") for (int _i = 0; _i < 2; ++_i) \
        __builtin_amdgcn_global_load_lds((const unsigned*)((const char*)(gbase) + (voff)[_i]), (PG8_LAS unsigned*)(lds + (bufoff) + ldsw + _i * 8192), 16, 0, 0); } while (0)
#define PG8_LDA(dst, b, h) do { _Pragma("unroll") for (int m = 0; m < 4; ++m) _Pragma("unroll") for (int k = 0; k < 2; ++k) dst[m][k] = *(const PG8_LAS bf16x8*)(lds + PG8_SA(b, h) + aoff + m * 2048 + k * 1024); } while (0)
#define PG8_LDB(dst, b, h) do { _Pragma("unroll") for (int n = 0; n < 2; ++n) _Pragma("unroll") for (int k = 0; k < 2; ++k) dst[n][k] = *(const PG8_LAS bf16x8*)(lds + PG8_SB(b, h) + boff + n * 2048 + k * 1024); } while (0)
#define PG8_MMA(ai, bj, At, Bt) do { __builtin_amdgcn_s_setprio(1); _Pragma("unroll") for (int m = 0; m < 4; ++m) _Pragma("unroll") for (int n = 0; n < 2; ++n) _Pragma("unroll") for (int k = 0; k < 2; ++k) \
        acc[ai][bj][m][n] = __builtin_amdgcn_mfma_f32_16x16x32_bf16(Bt[n][k], At[m][k], acc[ai][bj][m][n], 0, 0, 0); __builtin_amdgcn_s_setprio(0); } while (0)
#define PG8_WAIT_V(n) asm volatile("s_waitcnt vmcnt(" #n ")" ::: "memory")
#define PG8_WAIT_L(n) asm volatile("s_waitcnt lgkmcnt(" #n ")" ::: "memory")
#define PG8_BAR __builtin_amdgcn_s_barrier()
#define PG8_SCHED __builtin_amdgcn_sched_barrier(0)
    Unit cur, nxt; int ui = 0; int cseg = 0;
    if (!S.next(0, cur)) return;
    f32x4 acc[2][2][4][2];
#pragma unroll
    for (int a = 0; a < 2; ++a)
#pragma unroll
        for (int b = 0; b < 2; ++b)
#pragma unroll
            for (int m = 0; m < 4; ++m)
#pragma unroll
                for (int n = 0; n < 2; ++n) acc[a][b][m][n] = (f32x4){0.f, 0.f, 0.f, 0.f};
    bf16x8 At[4][2], B0[2][2], B1[2][2];
    const char* cA = (const char*)g.A + (size_t)cur.pm * tstep; const char* cB = (const char*)g.Bt + (size_t)cur.pn * tstep;
    if constexpr (SP2) {
        PG8_STAGE(PG8_SB(0, 0), cB, voffB); PG8_STAGE(PG8_SB(0, 1), cB + hstep, voffB); PG8_STAGE(PG8_SA(0, 0), cA, voffA); PG8_STAGE(PG8_SA(0, 1), cA + hstep, voffA);
        if (wr == 1) PG8_BAR;
        PG8_WAIT_V(2); PG8_BAR;
        PG8_STAGE(PG8_SB(1, 0), cB + kstep, voffB); PG8_STAGE(PG8_SA(1, 0), cA + kstep, voffA); PG8_STAGE(PG8_SB(1, 1), cB + hstep + kstep, voffB);
        PG8_WAIT_V(6); PG8_BAR;
    } else {
        PG8_STAGE(PG8_SB(0, 0), cB, voffB); PG8_STAGE(PG8_SA(0, 0), cA, voffA); PG8_STAGE(PG8_SB(0, 1), cB + hstep, voffB); PG8_STAGE(PG8_SA(0, 1), cA + hstep, voffA);
        if (wr == 1) PG8_BAR;
        PG8_WAIT_V(4); PG8_BAR;
        PG8_STAGE(PG8_SB(1, 0), cB + kstep, voffB); PG8_STAGE(PG8_SA(1, 0), cA + kstep, voffA); PG8_STAGE(PG8_SB(1, 1), cB + hstep + kstep, voffB);
        PG8_WAIT_V(6); PG8_BAR;
    }
    for (;;) {
        const int nseg = cseg ^ 1; bool has_next; if (cseg == 0) { nxt = cur; has_next = true; } else has_next = S.next((ui >> 1) + 1, nxt);
        const int nt = cseg ? nt1 : nt0;
        const char* nA = has_next ? (const char*)(nseg ? A1 : g.A) + (size_t)nxt.pm * tstep : cA; const char* nB = has_next ? (const char*)(nseg ? Bt1 : g.Bt) + (size_t)nxt.pn * tstep : cB;
        for (int t = 0; t < nt; t += 2) {
            const bool last = (t == nt - 2);
            const char* a1 = cA + (size_t)(t + 1) * kstep;
            const char* a2 = last ? nA : cA + (size_t)(t + 2) * kstep; const char* b2 = last ? nB : cB + (size_t)(t + 2) * kstep;
            const char* a3 = a2 + kstep; const char* b3 = b2 + kstep;
            if constexpr (SP2) {
            PG8_LDB(B0, 0, 0); PG8_LDB(B1, 0, 1); PG8_SCHED; PG8_LDA(At, 0, 0); PG8_STAGE(PG8_SA(1, 1), a1 + hstep, voffA);
            PG8_WAIT_V(8); PG8_WAIT_L(0); PG8_BAR; PG8_MMA(0, 0, At, B0); PG8_MMA(0, 1, At, B1); PG8_BAR; PG8_SCHED;
            PG8_LDA(At, 0, 1); PG8_STAGE(PG8_SB(0, 0), b2, voffB); PG8_STAGE(PG8_SB(0, 1), b2 + hstep, voffB); PG8_STAGE(PG8_SA(0, 0), a2, voffA);
            PG8_WAIT_V(8); PG8_WAIT_L(0); PG8_BAR; PG8_MMA(1, 0, At, B0); PG8_MMA(1, 1, At, B1); PG8_BAR; PG8_SCHED;
            PG8_LDB(B0, 1, 0); PG8_LDB(B1, 1, 1); PG8_SCHED; PG8_LDA(At, 1, 0); PG8_STAGE(PG8_SA(0, 1), a2 + hstep, voffA);
            PG8_WAIT_V(8); PG8_WAIT_L(0); PG8_BAR; PG8_MMA(0, 0, At, B0); PG8_MMA(0, 1, At, B1); PG8_BAR; PG8_SCHED;
            PG8_LDA(At, 1, 1); PG8_STAGE(PG8_SB(1, 0), b3, voffB); PG8_STAGE(PG8_SB(1, 1), b3 + hstep, voffB); PG8_STAGE(PG8_SA(1, 0), a3, voffA);
            PG8_WAIT_V(8); PG8_WAIT_L(0); PG8_BAR; PG8_MMA(1, 0, At, B0); PG8_MMA(1, 1, At, B1); PG8_BAR; PG8_SCHED;
            } else {
            PG8_LDB(B0, 0, 0); PG8_SCHED; PG8_LDA(At, 0, 0); PG8_STAGE(PG8_SA(1, 1), a1 + hstep, voffA);
            PG8_WAIT_L(8); PG8_BAR; PG8_WAIT_L(0); PG8_MMA(0, 0, At, B0); PG8_BAR; PG8_SCHED;
            PG8_LDB(B1, 0, 1); PG8_STAGE(PG8_SB(0, 0), b2, voffB);
            PG8_BAR; PG8_WAIT_L(0); PG8_MMA(0, 1, At, B1); PG8_BAR;
            PG8_LDA(At, 0, 1); PG8_STAGE(PG8_SA(0, 0), a2, voffA);
            PG8_BAR; PG8_WAIT_L(0); PG8_MMA(1, 0, At, B0); PG8_BAR; PG8_SCHED;
            PG8_STAGE(PG8_SB(0, 1), b2 + hstep, voffB);
            PG8_WAIT_V(6); PG8_BAR; PG8_MMA(1, 1, At, B1); PG8_BAR;
            PG8_LDB(B0, 1, 0); PG8_SCHED; PG8_LDA(At, 1, 0); PG8_STAGE(PG8_SA(0, 1), a2 + hstep, voffA);
            PG8_WAIT_L(8); PG8_BAR; PG8_WAIT_L(0); PG8_MMA(0, 0, At, B0); PG8_BAR; PG8_SCHED;
            PG8_LDB(B1, 1, 1); PG8_STAGE(PG8_SB(1, 0), b3, voffB);
            PG8_BAR; PG8_WAIT_L(0); PG8_MMA(0, 1, At, B1); PG8_BAR;
            PG8_LDA(At, 1, 1); PG8_STAGE(PG8_SA(1, 0), a3, voffA);
            PG8_BAR; PG8_WAIT_L(0); PG8_MMA(1, 0, At, B0); PG8_BAR; PG8_SCHED;
            PG8_STAGE(PG8_SB(1, 1), b3 + hstep, voffB);
            PG8_WAIT_V(6); PG8_BAR; PG8_MMA(1, 1, At, B1); PG8_BAR;
            }
        }
        if constexpr (ALIGN_EPI) { if (wr == 0) PG8_BAR; }
        if (cseg == 0) E.mid(acc, cur, wr, wc, fr, fq); else E(acc, cur, wr, wc, fr, fq);
        if (!has_next) break;
        if (cseg == 1) {
#pragma unroll
        for (int a = 0; a < 2; ++a)
#pragma unroll
            for (int b = 0; b < 2; ++b)
#pragma unroll
                for (int m = 0; m < 4; ++m)
#pragma unroll
                    for (int n = 0; n < 2; ++n) acc[a][b][m][n] = (f32x4){0.f, 0.f, 0.f, 0.f};
        }
        cur = nxt; cA = nA; cB = nB; ++ui; cseg = nseg;
        if constexpr (ALIGN_EPI) { if (wr == 1) PG8_BAR; }
    }
    PG8_WAIT_V(0);
    if constexpr (!ALIGN_EPI) { if (wr == 0) PG8_BAR; }
    PG8_BAR;
#undef PG8_SA
#undef PG8_SB
#undef PG8_STAGE
#undef PG8_LDA
#undef PG8_LDB
#undef PG8_MMA
#undef PG8_WAIT_V
#undef PG8_WAIT_L
#undef PG8_BAR
#undef PG8_SCHED
}
}
#ifndef PHM
#define PHM 255
#endif
#ifndef PROBE_DUP
#define PROBE_DUP 0
#endif
namespace mk {
__device__ __forceinline__ int fresh_tid() { int t = threadIdx.x; asm volatile("" : "+v"(t)); return t; }
using pg8::bf16_t; using pg8::f32x4; using pg8::u32x4; using pg8::Unit;
#define LAS __attribute__((address_space(3)))
typedef short bf16x8 __attribute__((ext_vector_type(8)));
typedef float f32x16 __attribute__((ext_vector_type(16)));
typedef short s16x4 __attribute__((ext_vector_type(4)));
typedef short v4i16_t __attribute__((ext_vector_type(4)));

constexpr int NB = 8, S_ = 4096, D_ = 1024, M_ = NB * S_, IN_ = 3584, NGATE = 2048, NCAT = IN_ + NGATE, FF = 4096, POOL = 512, DEPTH = 2;
constexpr float EPS = 1e-6f, LOG2E = 1.4426950408889634f;
constexpr size_t MiB = 1u << 20;
constexpr size_t WS_RS = 1 * MiB;
constexpr size_t WS_W = 3 * MiB;
constexpr size_t WO_CAT = 0, WO_COMB = (size_t)NCAT * 1024, WO_BA = WO_COMB + 1024 * 512, WO_OUT = WO_BA + 1024 * 1024, WO_UP = WO_OUT + 1024 * 1024, WO_DOWN = WO_UP + 4096 * 1024;
constexpr size_t WS_XBF = 35 * MiB;
constexpr size_t WS_U = 99 * MiB;
constexpr size_t WS_Q = 131 * MiB;
constexpr size_t WS_K = 195 * MiB;
constexpr size_t WS_V = 259 * MiB;
constexpr size_t WS_G = 323 * MiB;
constexpr size_t WS_YP = 451 * MiB;
constexpr size_t WS_MRG = WS_K;
constexpr size_t WS_H = WS_U;
constexpr size_t WS_END = 483 * MiB;
constexpr int LDS_BYTES = 147456;

__device__ __forceinline__ unsigned pk2(float lo, float hi) { return pg8::cvt_pk_bf16(lo, hi); }
__device__ __forceinline__ float bflo(unsigned w) { return __uint_as_float(w << 16); }
__device__ __forceinline__ float bfhi(unsigned w) { return __uint_as_float(w & 0xffff0000u); }
__device__ __forceinline__ float wave_sum(float v) {
#pragma unroll
    for (int o = 1; o < 64; o <<= 1) v += __shfl_xor(v, o);
    return v;
}
__device__ __forceinline__ float wave_max(float v) {
#pragma unroll
    for (int o = 1; o < 64; o <<= 1) v = fmaxf(v, __shfl_xor(v, o));
    return v;
}
__device__ __forceinline__ float rstd_row(const float* RS, int row, int fq) {
    const f32x4 v = *(const f32x4*)(RS + (size_t)row * 16 + 4 * fq);
    float s = (v[0] + v[1]) + (v[2] + v[3]);
    s += __shfl_xor(s, 16); s += __shfl_xor(s, 32);
    return rsqrtf(s * (1.0f / 1024.0f) + EPS);
}
__device__ __forceinline__ float sigmoidf_(float z) { return __builtin_amdgcn_rcpf(1.0f + __builtin_amdgcn_exp2f(-z * LOG2E)); }

struct EpiIn {
    static constexpr bool PERM = true, AFTER_DRAIN = false;
    bf16_t *U, *Q, *K, *V, *G; const float* RS; const float* gq; const float* gk; const float* bgate;
    __device__ __forceinline__ void operator()(const f32x4 (&acc)[2][2][4][2], const Unit& u, int wr, int wc, int fr, int fq) const {
        const int row0 = u.pm * 256 + wr * 64 + fr, pn = u.pn;
        if (pn >= 2 && pn < 10) {
            const bool isq = pn < 6; bf16_t* base = isq ? Q : K; const int colt = (pn - (isq ? 2 : 6)) * 256 + 64 * wc + 8 * fq;
            const float* g = isq ? gq : gk; const float sc = isq ? 0.125f * LOG2E : 1.0f;
            f32x4 gv[2][2];
#pragma unroll
            for (int bj = 0; bj < 2; ++bj)
#pragma unroll
                for (int n = 0; n < 2; ++n) gv[bj][n] = *(const f32x4*)(g + 32 * bj + 8 * fq + 4 * n) * sc;
#pragma unroll
            for (int ai = 0; ai < 2; ++ai)
#pragma unroll
                for (int m = 0; m < 4; ++m) {
                    const int row = row0 + ai * 128 + m * 16; const float r = rstd_row(RS, row, fq);
                    f32x4 v[2][2]; float ss = 0.f;
#pragma unroll
                    for (int bj = 0; bj < 2; ++bj)
#pragma unroll
                        for (int n = 0; n < 2; ++n) { v[bj][n] = acc[ai][bj][m][n] * r; const f32x4 q = v[bj][n] * v[bj][n]; ss += (q[0] + q[1]) + (q[2] + q[3]); }
                    ss += __shfl_xor(ss, 16); ss += __shfl_xor(ss, 32);
                    const float rn = rsqrtf(ss * (1.0f / 64.0f) + EPS);
                    bf16_t* rowp = base + (size_t)row * 1024 + colt;
#pragma unroll
                    for (int bj = 0; bj < 2; ++bj) { const f32x4 v0 = v[bj][0] * rn * gv[bj][0], v1 = v[bj][1] * rn * gv[bj][1];
                        u32x4 w; w.x = pk2(v0[0], v0[1]); w.y = pk2(v0[2], v0[3]); w.z = pk2(v1[0], v1[1]); w.w = pk2(v1[2], v1[3]);
                        __builtin_nontemporal_store(w, (u32x4*)(rowp + 32 * bj)); }
                }
        } else {
            bf16_t* base; int ld, colt; bool sg = false;
            if (pn < 2) { base = U; ld = 512; colt = pn * 256; } else if (pn < 14) { base = V; ld = 1024; colt = (pn - 10) * 256; } else { base = G; ld = 2048; colt = (pn - 14) * 256; sg = true; }
            const int col0 = colt + wc * 32 + 8 * fq;
            f32x4 bv[2][2];
#pragma unroll
            for (int bj = 0; bj < 2; ++bj)
#pragma unroll
                for (int n = 0; n < 2; ++n) bv[bj][n] = sg ? *(const f32x4*)(bgate + col0 + bj * 128 + 4 * n) : (f32x4){0.f, 0.f, 0.f, 0.f};
#pragma unroll
            for (int ai = 0; ai < 2; ++ai)
#pragma unroll
                for (int m = 0; m < 4; ++m) {
                    const int row = row0 + ai * 128 + m * 16; const float r = rstd_row(RS, row, fq);
                    bf16_t* rowp = base + (size_t)row * ld + col0;
#pragma unroll
                    for (int bj = 0; bj < 2; ++bj) { f32x4 v0 = acc[ai][bj][m][0] * r + bv[bj][0], v1 = acc[ai][bj][m][1] * r + bv[bj][1];
                        if (sg) {
#pragma unroll
                            for (int i = 0; i < 4; ++i) { v0[i] = sigmoidf_(v0[i]); v1[i] = sigmoidf_(v1[i]); } }
                        u32x4 w; w.x = pk2(v0[0], v0[1]); w.y = pk2(v0[2], v0[3]); w.z = pk2(v1[0], v1[1]); w.w = pk2(v1[2], v1[3]);
                        __builtin_nontemporal_store(w, (u32x4*)(rowp + bj * 128)); }
                }
        }
    }
};
struct EpiMerge2 {
    static constexpr bool PERM = true, AFTER_DRAIN = false;
    const bf16_t* G; bf16_t* MRG;
    __device__ __forceinline__ void mid(f32x4 (&acc)[2][2][4][2], const Unit& u, int wr, int wc, int fr, int fq) const {
        const int row0 = u.pm * 256 + wr * 64 + fr, col0 = u.pn * 256 + wc * 32 + 8 * fq;
#pragma unroll
        for (int ai = 0; ai < 2; ++ai)
#pragma unroll
            for (int m = 0; m < 4; ++m) {
                const int row = row0 + ai * 128 + m * 16;
#pragma unroll
                for (int bj = 0; bj < 2; ++bj) {
                    const bf16_t* gp = G + (size_t)row * 2048 + col0 + bj * 128;
                    const u32x4 g0 = *(const u32x4*)gp, g1 = *(const u32x4*)(gp + 1024);
#define MK_RT(a, b) ((a) * __builtin_amdgcn_rcpf(fmaxf((b), 1e-30f)))
                    f32x4& v0 = acc[ai][bj][m][0]; f32x4& v1 = acc[ai][bj][m][1];
                    v0[0] *= MK_RT(bflo(g0.x), bflo(g1.x)); v0[1] *= MK_RT(bfhi(g0.x), bfhi(g1.x)); v0[2] *= MK_RT(bflo(g0.y), bflo(g1.y)); v0[3] *= MK_RT(bfhi(g0.y), bfhi(g1.y));
                    v1[0] *= MK_RT(bflo(g0.z), bflo(g1.z)); v1[1] *= MK_RT(bfhi(g0.z), bfhi(g1.z)); v1[2] *= MK_RT(bflo(g0.w), bflo(g1.w)); v1[3] *= MK_RT(bfhi(g0.w), bfhi(g1.w));
#undef MK_RT
                }
            }
    }
    __device__ __forceinline__ void operator()(const f32x4 (&acc)[2][2][4][2], const Unit& u, int wr, int wc, int fr, int fq) const {
        const int row0 = u.pm * 256 + wr * 64 + fr, col0 = u.pn * 256 + wc * 32 + 8 * fq;
#pragma unroll
        for (int ai = 0; ai < 2; ++ai)
#pragma unroll
            for (int m = 0; m < 4; ++m) {
                const int row = row0 + ai * 128 + m * 16;
#pragma unroll
                for (int bj = 0; bj < 2; ++bj) {
                    const u32x4 gw = *(const u32x4*)(G + (size_t)row * 2048 + 1024 + col0 + bj * 128);
                    f32x4 v0 = acc[ai][bj][m][0], v1 = acc[ai][bj][m][1];
                    v0[0] *= bflo(gw.x); v0[1] *= bfhi(gw.x); v0[2] *= bflo(gw.y); v0[3] *= bfhi(gw.y);
                    v1[0] *= bflo(gw.z); v1[1] *= bfhi(gw.z); v1[2] *= bflo(gw.w); v1[3] *= bfhi(gw.w);
                    u32x4 w; w.x = pk2(v0[0], v0[1]); w.y = pk2(v0[2], v0[3]); w.z = pk2(v1[0], v1[1]); w.w = pk2(v1[2], v1[3]);
                    *(u32x4*)(MRG + (size_t)row * 1024 + col0 + bj * 128) = w; }
            }
    }
};
struct EpiResid {
    static constexpr bool PERM = true, AFTER_DRAIN = false;
    float* out; bf16_t* xbf; float* RS; int wr_aux;
    __device__ __forceinline__ void operator()(const f32x4 (&acc)[2][2][4][2], const Unit& u, int wr, int wc, int fr, int fq) const {
        const int row0 = u.pm * 256 + wr * 64 + fr, col0 = u.pn * 256 + wc * 32 + 8 * fq;
#pragma unroll
        for (int ai = 0; ai < 2; ++ai)
#pragma unroll
            for (int m = 0; m < 4; ++m) {
                const int row = row0 + ai * 128 + m * 16; float ss = 0.f;
#pragma unroll
                for (int bj = 0; bj < 2; ++bj) {
                    const size_t off = (size_t)row * 1024 + col0 + bj * 128;
                    const u32x4 xw = *(const u32x4*)(xbf + off);
                    f32x4 v0 = acc[ai][bj][m][0], v1 = acc[ai][bj][m][1];
                    v0[0] += bflo(xw.x); v0[1] += bfhi(xw.x); v0[2] += bflo(xw.y); v0[3] += bfhi(xw.y);
                    v1[0] += bflo(xw.z); v1[1] += bfhi(xw.z); v1[2] += bflo(xw.w); v1[3] += bfhi(xw.w);
                    if (wr_aux) {
                        const f32x4 q0 = v0 * v0, q1 = v1 * v1; ss += ((q0[0] + q0[1]) + (q0[2] + q0[3])) + ((q1[0] + q1[1]) + (q1[2] + q1[3]));
                        u32x4 w; w.x = pk2(v0[0], v0[1]); w.y = pk2(v0[2], v0[3]); w.z = pk2(v1[0], v1[1]); w.w = pk2(v1[2], v1[3]);
                        *(u32x4*)(xbf + off) = w;
                    } else { *(f32x4*)(out + off) = v0; *(f32x4*)(out + off + 4) = v1; }
                }
                if (wr_aux) { ss += __shfl_xor(ss, 16); ss += __shfl_xor(ss, 32); if (fq == 0) RS[(size_t)row * 16 + u.pn * 4 + wc] = ss; }
            }
    }
};
struct EpiUp {
    static constexpr bool PERM = true, AFTER_DRAIN = false;
    bf16_t* H; const float* RS;
    __device__ __forceinline__ void operator()(const f32x4 (&acc)[2][2][4][2], const Unit& u, int wr, int wc, int fr, int fq) const {
        const int row0 = u.pm * 256 + wr * 64 + fr, col0 = u.pn * 256 + wc * 32 + 8 * fq;
#pragma unroll
        for (int ai = 0; ai < 2; ++ai)
#pragma unroll
            for (int m = 0; m < 4; ++m) {
                const int row = row0 + ai * 128 + m * 16; const float r = rstd_row(RS, row, fq);
#pragma unroll
                for (int bj = 0; bj < 2; ++bj) {
                    f32x4 v0 = acc[ai][bj][m][0] * r, v1 = acc[ai][bj][m][1] * r;
#pragma unroll
                    for (int i = 0; i < 4; ++i) { const float a = fmaxf(v0[i], 0.f), b = fmaxf(v1[i], 0.f); v0[i] = a * a; v1[i] = b * b; }
                    u32x4 w; w.x = pk2(v0[0], v0[1]); w.y = pk2(v0[2], v0[3]); w.z = pk2(v1[0], v1[1]); w.w = pk2(v1[2], v1[3]);
                    __builtin_nontemporal_store(w, (u32x4*)(H + (size_t)row * FF + col0 + bj * 128)); }
            }
    }
};

__device__ __forceinline__ int qk_perm_row(int n) {
    if (n < 512 || n >= 2560) return n;
    const int c = n - 512; return 512 + (c & ~255) + 128 * ((c >> 5) & 1) + 32 * ((c >> 6) & 3) + (c & 31);
}
__device__ __forceinline__ void transpose_item(const float* W, int K, int N, bf16_t* WT, int row_off, const float* gk, bool permqk, LAS float* scr, int item, int lane) {
    const int nblk = N / 64, kb = item / nblk, nb = item % nblk, k0 = 64 * kb, n0 = 64 * nb, kr = lane >> 4, nc = lane & 15;
    f32x4 v[16];
#pragma unroll
    for (int i = 0; i < 16; ++i) v[i] = *(const f32x4*)(W + (size_t)(k0 + 4 * i + kr) * N + n0 + 4 * nc);
    if (gk) {
#pragma unroll
        for (int i = 0; i < 16; ++i) v[i] = v[i] * gk[k0 + 4 * i + kr];
    }
#pragma unroll
    for (int i = 0; i < 16; ++i)
#pragma unroll
        for (int e = 0; e < 4; ++e) scr[(4 * nc + e) * 65 + 4 * i + kr] = v[i][e];
    asm volatile("s_waitcnt lgkmcnt(0)" ::: "memory");
    const int c = lane & 7;
#pragma unroll
    for (int j = 0; j < 8; ++j) { const int n = (lane >> 3) + 8 * j; const LAS float* s = scr + n * 65 + 8 * c;
        u32x4 o; o.x = pk2(s[0], s[1]); o.y = pk2(s[2], s[3]); o.z = pk2(s[4], s[5]); o.w = pk2(s[6], s[7]);
        const int dr = permqk ? qk_perm_row(n0 + n) : (n0 + n);
        *(u32x4*)(WT + (size_t)(row_off + dr) * K + k0 + 8 * c) = o; }
    asm volatile("s_waitcnt lgkmcnt(0)" ::: "memory");
}

struct Args { const float* in[17]; float* out; unsigned char* ws; };

__device__ __forceinline__ void p0_phase(const Args& a, int l, LAS unsigned char* lds, int vcu, int G) {
    const int tid = fresh_tid(), lane = tid & 63, wave = __builtin_amdgcn_readfirstlane(tid >> 6);
    LAS float* scr = (LAS float*)(lds + wave * 16640);
    const int gw = vcu * 8 + wave, NGW = G * 8;
    bf16_t* Wb = (bf16_t*)(a.ws + WS_W);
    if (blockIdx.x == 0 && tid < 16) ((unsigned*)a.ws)[64 * tid] = 0u;
    const float* g_mix = a.in[1] + (size_t)l * 1024; const float* w_in = a.in[2] + (size_t)l * 1024 * IN_;
    const float* w_grp = a.in[3] + (size_t)l * 4 * 128 * 128; const float* pscale = a.in[4] + (size_t)l * 512;
    const float* w_bp = a.in[9] + (size_t)l * 512 * 1024; const float* w_ba = a.in[10] + (size_t)l * 1024 * 1024;
    const float* w_gate = a.in[11] + (size_t)l * 1024 * NGATE; const float* w_out = a.in[13] + (size_t)l * 1024 * 1024;
    const float* g_ffn = a.in[14] + (size_t)l * 1024; const float* w_up = a.in[15] + (size_t)l * 1024 * FF; const float* w_down = a.in[16] + (size_t)l * FF * 1024;
    constexpr int I_IN = 16 * (IN_ / 64), I_GATE = 16 * (NGATE / 64), I_BA = 16 * 16, I_OUT = 16 * 16, I_UP = 16 * (FF / 64), I_DOWN = 64 * 16;
    constexpr int NITEMS = I_IN + I_GATE + I_BA + I_OUT + I_UP + I_DOWN;
    for (int it = gw; it < NITEMS; it += NGW) {
        int r = it;
        if (r < I_IN) { transpose_item(w_in, 1024, IN_, Wb + WO_CAT, 0, g_mix, true, scr, r, lane); continue; } r -= I_IN;
        if (r < I_GATE) { transpose_item(w_gate, 1024, NGATE, Wb + WO_CAT, IN_, g_mix, false, scr, r, lane); continue; } r -= I_GATE;
        if (r < I_BA) { transpose_item(w_ba, 1024, 1024, Wb + WO_BA, 0, nullptr, false, scr, r, lane); continue; } r -= I_BA;
        if (r < I_OUT) { transpose_item(w_out, 1024, 1024, Wb + WO_OUT, 0, nullptr, false, scr, r, lane); continue; } r -= I_OUT;
        if (r < I_UP) { transpose_item(w_up, 1024, FF, Wb + WO_UP, 0, g_ffn, false, scr, r, lane); continue; } r -= I_UP;
        transpose_item(w_down, FF, 1024, Wb + WO_DOWN, 0, nullptr, false, scr, r, lane);
    }
    __syncthreads();
    for (int it = vcu; it < 64; it += G) {
        const int g = it >> 4, cb = (it >> 1) & 7, n = (it & 1) * 512 + tid;
        LAS float* wl = (LAS float*)lds;
#pragma unroll
        for (int j = 0; j < 4; ++j) { const int e = tid + 512 * j, cc = e >> 7, d = e & 127; wl[e] = w_grp[((size_t)g * 128 + cb * 16 + cc) * 128 + d] * pscale[g * 128 + d]; }
        __syncthreads();
        const float* bp = w_bp + (size_t)(g * 128) * 1024 + n;
        float acc[16];
#pragma unroll
        for (int cc = 0; cc < 16; ++cc) acc[cc] = 0.f;
#pragma unroll 8
        for (int d = 0; d < 128; ++d) { const float bv = bp[(size_t)d * 1024];
#pragma unroll
            for (int cc = 0; cc < 16; ++cc) acc[cc] += wl[cc * 128 + d] * bv; }
        u32x4 o0, o1;
        o0.x = pk2(acc[0], acc[1]); o0.y = pk2(acc[2], acc[3]); o0.z = pk2(acc[4], acc[5]); o0.w = pk2(acc[6], acc[7]);
        o1.x = pk2(acc[8], acc[9]); o1.y = pk2(acc[10], acc[11]); o1.z = pk2(acc[12], acc[13]); o1.w = pk2(acc[14], acc[15]);
        bf16_t* op = (bf16_t*)(a.ws + WS_YP) + (size_t)n * 1024 + g * 128 + cb * 16;
        *(u32x4*)op = o0; *(u32x4*)(op + 8) = o1;
        __syncthreads();
    }
    if (l == 0) {
        const float* x = a.in[0]; bf16_t* xbf = (bf16_t*)(a.ws + WS_XBF); float* RS = (float*)(a.ws + WS_RS);
        for (int m = gw; m < M_; m += NGW) {
            const f32x4* xr = (const f32x4*)(x + (size_t)m * 1024) + lane; f32x4 v[4]; float s = 0.f;
#pragma unroll
            for (int j = 0; j < 4; ++j) { v[j] = xr[64 * j]; const f32x4 q = v[j] * v[j]; s += (q[0] + q[1]) + (q[2] + q[3]); }
            s = wave_sum(s);
            unsigned long long* o8 = (unsigned long long*)(xbf + (size_t)m * 1024) + lane;
#pragma unroll
            for (int j = 0; j < 4; ++j) o8[64 * j] = (unsigned long long)pk2(v[j][0], v[j][1]) | ((unsigned long long)pk2(v[j][2], v[j][3]) << 32);
            if (lane < 16) RS[(size_t)m * 16 + lane] = lane == 0 ? s : 0.f;
        }
    }
}

template <int W> __device__ __forceinline__ void mix_item(const bf16_t* U, bf16_t* YP, int blk, int g, int lane) {
    const int sub = lane >> 4, ch = lane & 15, row0 = blk * 32 + sub * 8, t0 = row0 & (S_ - 1);
    const bf16_t* p = U + (size_t)row0 * 512 + g * 128 + ch * 8;
    u32x4 v[W + 7];
#pragma unroll
    for (int i = 0; i < W + 7; ++i) { const int dt = i - (W - 1); v[i] = (t0 + dt >= 0) ? *(const u32x4*)(p + (ptrdiff_t)dt * 512) : (u32x4){0u, 0u, 0u, 0u}; }
#pragma unroll
    for (int r = 0; r < 8; ++r) {
        float s0 = 0.f, s1 = 0.f, s2 = 0.f, s3 = 0.f, s4 = 0.f, s5 = 0.f, s6 = 0.f, s7 = 0.f;
#pragma unroll
        for (int j = 0; j < W; ++j) { const u32x4 x = v[r + W - 1 - j];
            s0 += bflo(x.x); s1 += bfhi(x.x); s2 += bflo(x.y); s3 += bfhi(x.y); s4 += bflo(x.z); s5 += bfhi(x.z); s6 += bflo(x.w); s7 += bfhi(x.w); }
        const int t = t0 + r; const float inv = 1.0f / (float)((t + 1 < W) ? (t + 1) : W); const u32x4 self = v[r + W - 1];
        u32x4 o; o.x = pk2(s0 * inv - bflo(self.x), s1 * inv - bfhi(self.x)); o.y = pk2(s2 * inv - bflo(self.y), s3 * inv - bfhi(self.y));
        o.z = pk2(s4 * inv - bflo(self.z), s5 * inv - bfhi(self.z)); o.w = pk2(s6 * inv - bflo(self.w), s7 * inv - bfhi(self.w));
        *(u32x4*)(YP + (size_t)(row0 + r) * 1024 + g * 128 + ch * 8) = o;
    }
}
__device__ __forceinline__ void mix_phase(const bf16_t* U, bf16_t* YP, int vcu, int G) {
    const int tid = fresh_tid(), lane = tid & 63, wave = __builtin_amdgcn_readfirstlane(tid >> 6);
    for (int it = vcu * 8 + wave; it < (M_ / 32) * 4; it += G * 8) {
        const int g = it & 3, blk = it >> 2;
        if (g == 0) mix_item<2>(U, YP, blk, 0, lane); else if (g == 1) mix_item<4>(U, YP, blk, 1, lane); else if (g == 2) mix_item<8>(U, YP, blk, 2, lane); else mix_item<16>(U, YP, blk, 3, lane);
    }
}

__device__ __forceinline__ int crow(int r, int hi) { return (r & 3) + 8 * (r >> 2) + 4 * hi; }
__device__ __forceinline__ s16x4 vtr(const LAS unsigned char* p) { return __builtin_bit_cast(s16x4, __builtin_amdgcn_ds_read_tr16_b64_v4i16((LAS v4i16_t*)p)); }
constexpr int AT_STG = 32768, AT_VOF = 16384, AT_WSF = 3 * AT_STG;
static_assert(AT_WSF + 2048 <= 131072 && AT_WSF >= 65536, "attention LDS map");
__device__ __forceinline__ void glds16(const void* gsrc, unsigned lds_dst) { unsigned keep;
    asm volatile("s_mov_b32 %0, m0\n\ts_mov_b32 m0, %2\n\ts_nop 0\n\tglobal_load_lds_dwordx4 %1, off\n\ts_mov_b32 m0, %0" : "=&s"(keep) : "v"(gsrc), "s"(lds_dst) : "memory"); }
#define AT_WAIT_BAR(N) asm volatile("s_waitcnt vmcnt(" #N ") lgkmcnt(0)\n\ts_barrier" ::: "memory")

__device__ __forceinline__ void attn_unit(int b, int h, int qb, const bf16_t* Q, const bf16_t* K, const bf16_t* V, bf16_t* O, const float* gsub, float lam, float oscale, float M2, int kt_lo, LAS unsigned char* lds, int tid, bool do_store = true) {
    const int lane = tid & 63, r32 = lane & 31, hi = lane >> 5, wid = __builtin_amdgcn_readfirstlane(tid >> 6), rg = wid & 3, mp = wid >> 2;
    const size_t rowbase = (size_t)b * S_; const int q0 = qb * 128;
    const bf16_t* Qw = Q + (rowbase + q0 + 32 * rg + r32) * 1024 + h * 128 + mp * 64 + hi * 8;
    bf16x8 qr[4];
#pragma unroll
    for (int d0 = 0; d0 < 4; ++d0) qr[d0] = *(const bf16x8*)(Qw + d0 * 16);
    const int NT = 2 * qb + 2, ktmax = 2 * qb + (rg >> 1);
    const float sl2 = __builtin_amdgcn_exp2f(-(float)(h + 1)) * LOG2E;
    const int drow = 8 * wid + (lane >> 4), dch = lane & 15;
    const bf16_t* ks0 = K + (rowbase + (size_t)kt_lo * 64 + drow) * 1024 + h * 128 + ((dch ^ (drow & 15)) << 3);
    const bf16_t* ks1 = K + (rowbase + (size_t)kt_lo * 64 + drow + 4) * 1024 + h * 128 + ((dch ^ ((drow + 4) & 15)) << 3);
    const bf16_t* vs0 = V + (rowbase + (size_t)kt_lo * 64 + drow) * 1024 + h * 128 + ((dch ^ ((drow & 3) << 2)) << 3);
    const bf16_t* vs1 = vs0 + 4 * 1024;
    const unsigned ldsb = (unsigned)(size_t)lds + (unsigned)wid * 2048u;
#define AT_DMA(stage) do { const unsigned d_ = (unsigned)__builtin_amdgcn_readfirstlane((int)(ldsb + (unsigned)(stage) * AT_STG)); \
        glds16(ks0, d_); glds16(ks1, d_ + 1024u); glds16(vs0, d_ + AT_VOF); glds16(vs1, d_ + AT_VOF + 1024u); \
        ks0 += 64 * 1024; ks1 += 64 * 1024; vs0 += 64 * 1024; vs1 += 64 * 1024; } while (0)
    int st_c = 0;
    AT_DMA(0);
    if (kt_lo + 1 < NT) AT_DMA(1);
    asm volatile("" :: "v"(qr[0]), "v"(qr[1]), "v"(qr[2]), "v"(qr[3]));
    f32x16 o[4];
#pragma unroll
    for (int c = 0; c < 4; ++c)
#pragma unroll
        for (int r = 0; r < 16; ++r) o[c][r] = 0.f;
    float l = 0.f;
    int kofs[4], vofs[4];
    { const int q4 = (lane & 15) >> 2, p4 = lane & 3, blk = (lane >> 4) & 1;
#pragma unroll
      for (int d0 = 0; d0 < 4; ++d0) kofs[d0] = r32 * 256 + (((mp * 8 + 2 * d0 + hi) ^ (r32 & 15)) << 4);
#pragma unroll
      for (int c = 0; c < 4; ++c) vofs[c] = AT_VOF + (4 * hi + q4) * 256 + ((((c ^ q4) << 2) | (blk << 1) | (p4 >> 1)) << 4) + 8 * (p4 & 1); }
    const float qposf = (float)(q0 + 32 * rg + r32 - 4 * hi);
    for (int kt = kt_lo; kt < NT; ++kt) {
        if (kt + 1 < NT) AT_WAIT_BAR(4); else AT_WAIT_BAR(0);
        if (kt + 2 < NT) AT_DMA(st_c == 0 ? 2 : st_c - 1);
        if (kt <= ktmax) {
            const LAS unsigned char* sb = lds + st_c * AT_STG;
            f32x16 s0, s1;
#pragma unroll
            for (int r = 0; r < 16; ++r) { s0[r] = -M2; s1[r] = -M2; }
#pragma unroll
            for (int d0 = 0; d0 < 4; ++d0) {
                const bf16x8 a0 = *(const LAS bf16x8*)(sb + kofs[d0]), a1 = *(const LAS bf16x8*)(sb + kofs[d0] + 32 * 256);
                s0 = __builtin_amdgcn_mfma_f32_32x32x16_bf16(a0, qr[d0], s0, 0, 0, 0);
                s1 = __builtin_amdgcn_mfma_f32_32x32x16_bf16(a1, qr[d0], s1, 0, 0, 0);
            }
            s16x4 va[4][2], vc[4][2];
#define AT_VRD(dst, ks) do { _Pragma("unroll") for (int c = 0; c < 4; ++c) { dst[c][0] = vtr(sb + vofs[c] + (ks) * 16 * 256); dst[c][1] = vtr(sb + vofs[c] + (ks) * 16 * 256 + 8 * 256); } } while (0)
#define AT_VMM(src, ks) do { _Pragma("unroll") for (int c = 0; c < 4; ++c) { const bf16x8 vf = (bf16x8){src[c][0][0], src[c][0][1], src[c][0][2], src[c][0][3], src[c][1][0], src[c][1][1], src[c][1][2], src[c][1][3]}; \
                o[c] = __builtin_amdgcn_mfma_f32_32x32x16_bf16(__builtin_bit_cast(bf16x8, pw[ks]), vf, o[c], 0, 0, 0); } } while (0)
            AT_VRD(va, 0);
            __builtin_amdgcn_sched_barrier(0);
            const float dq = qposf - (float)(kt * 64);
            float ls = 0.f;
#pragma unroll
            for (int r = 0; r < 16; ++r) { const float d = dq - (float)((r & 3) + 8 * (r >> 2));
                s0[r] = __builtin_amdgcn_exp2f(__builtin_fmaf(-sl2, __builtin_fabsf(d), s0[r]));
                s1[r] = __builtin_amdgcn_exp2f(__builtin_fmaf(-sl2, __builtin_fabsf(d - 32.0f), s1[r]));
                ls += s0[r] + s1[r]; }
            l += ls;
            u32x4 pw[4];
#pragma unroll
            for (int j = 0; j < 4; ++j) { pw[0][j] = pk2(s0[2 * j], s0[2 * j + 1]); pw[1][j] = pk2(s0[8 + 2 * j], s0[8 + 2 * j + 1]); pw[2][j] = pk2(s1[2 * j], s1[2 * j + 1]); pw[3][j] = pk2(s1[8 + 2 * j], s1[8 + 2 * j + 1]); }
            __builtin_amdgcn_sched_barrier(0);
            AT_VRD(vc, 1); __builtin_amdgcn_sched_barrier(0);
            AT_VMM(va, 0); __builtin_amdgcn_sched_barrier(0);
            AT_VRD(va, 2); __builtin_amdgcn_sched_barrier(0);
            AT_VMM(vc, 1); __builtin_amdgcn_sched_barrier(0);
            AT_VRD(vc, 3); __builtin_amdgcn_sched_barrier(0);
            AT_VMM(va, 2); __builtin_amdgcn_sched_barrier(0);
            AT_VMM(vc, 3); __builtin_amdgcn_sched_barrier(0);
#undef AT_VRD
#undef AT_VMM
        }
        st_c = (st_c == 2) ? 0 : st_c + 1;
    }
    AT_WAIT_BAR(0);
#undef AT_DMA
    l += __shfl_xor(l, 32);
    LAS float* wsf = (LAS float*)(lds + AT_WSF) + wid * 64;
    if (hi == 0) wsf[r32] = l;
    asm volatile("s_waitcnt lgkmcnt(0)" ::: "memory");
#pragma unroll
    for (int r = 0; r < 16; ++r) { const float rl = 1.0f / wsf[crow(r, hi)];
#pragma unroll
        for (int c = 0; c < 4; ++c) o[c][r] *= rl; }
    LAS float* X = (LAS float*)lds + rg * 4096;
    if (mp == 1) {
#pragma unroll
        for (int c = 0; c < 4; ++c)
#pragma unroll
            for (int r = 0; r < 16; ++r) X[crow(r, hi) * 128 + 32 * c + r32] = o[c][r];
    }
    __syncthreads();
    if (mp == 0 && do_store) {
        float gs[4];
#pragma unroll
        for (int c = 0; c < 4; ++c) gs[c] = gsub[32 * c + r32] * oscale;
#pragma unroll
        for (int r = 0; r < 16; ++r) {
            float ss = 0.f;
#pragma unroll
            for (int c = 0; c < 4; ++c) { o[c][r] -= lam * X[crow(r, hi) * 128 + 32 * c + r32]; ss += o[c][r] * o[c][r]; }
            ss += __shfl_xor(ss, 1); ss += __shfl_xor(ss, 2); ss += __shfl_xor(ss, 4); ss += __shfl_xor(ss, 8); ss += __shfl_xor(ss, 16);
            const float rn = rsqrtf(ss * (1.0f / 128.0f) + EPS);
            bf16_t* op = O + (rowbase + q0 + 32 * rg + crow(r, hi)) * 1024 + h * 128 + r32;
#pragma unroll
            for (int c = 0; c < 4; ++c) op[32 * c] = (bf16_t)(pk2(o[c][r] * rn * gs[c], 0.f) & 0xffffu);
        }
    }
    __syncthreads();
}

constexpr int AT_ORD = 131072;
constexpr float AT_THR2 = 40.0f;
__device__ __forceinline__ void attn_phase(const Args& a, int l, LAS unsigned char* lds, int bx, int pass = 0, bool do_store = true) {
    const int tid = fresh_tid(), lane = tid & 63;
    const float* gq = a.in[5] + l * 64; const float* gk = a.in[6] + l * 64; const float* lq = a.in[7] + l * 256; const float* gsub = a.in[8] + l * 128;
    const float lambda_init = 0.8f - 0.6f * expf(-0.3f * (float)l);
    const float lam = expf(wave_sum(lq[lane] * lq[64 + lane])) - expf(wave_sum(lq[128 + lane] * lq[192 + lane])) + lambda_init;
    const float M2 = 8.0f * wave_max(fabsf(gq[lane])) * wave_max(fabsf(gk[lane])) * LOG2E;
    const bf16_t* Q = (const bf16_t*)(a.ws + WS_Q); const bf16_t* K = (const bf16_t*)(a.ws + WS_K); const bf16_t* V = (const bf16_t*)(a.ws + WS_V);
    LAS int* ord = (LAS int*)(lds + AT_ORD); LAS int* cst = ord + 256; LAS int* cur = cst + 256;
    unsigned* ctr = (unsigned*)a.ws + 512 * pass;
    int my_lo = 0;
    if (tid < 256) {
        const int h = tid >> 5, qb = tid & 31;
        const float sl2 = __builtin_amdgcn_exp2f(-(float)(h + 1)) * LOG2E, Wd = (2.0f * M2 + AT_THR2) / sl2;
        const float x = ((float)(128 * qb - 63) - Wd) * (1.0f / 64.0f);
        my_lo = x > 0.f ? (int)ceilf(x) : 0;
        cst[tid] = ((2 * qb + 2 - my_lo) << 8) | my_lo;
    }
    if (tid < 256) ord[(7 - (tid >> 5)) * 32 + 31 - (tid & 31)] = tid;
    __syncthreads();
    const int xcc = (int)(__builtin_amdgcn_s_getreg((3 << 11) | 20) & 0xFu) & 7;
    for (int qi = 0; qi < 8; ++qi) {
        const int qx = (xcc + qi) & 7;
        for (;;) {
            if (tid == 0) cur[0] = (int)__hip_atomic_fetch_add(ctr + 64 * qx, 1u, __ATOMIC_RELAXED, __HIP_MEMORY_SCOPE_AGENT);
            __syncthreads();
            const int idx = cur[0];
            __syncthreads();
            if (idx >= 256) break;
            const int t = ord[idx], klo = cst[t] & 255;
            attn_unit(qx, t >> 5, t & 31, Q, K, V, (bf16_t*)(a.ws + WS_Q), gsub, lam, 1.0f - lambda_init, M2, klo, lds, tid, do_store);
        }
    }
}

#define XB_TMO      128
#define XB_XCNT(j)  (256  + 64 * (j))
#define XB_XSUB(j)  (1280 + 64 * (j))
#define XB_XGEN(j)  (2304 + 64 * (j))
#define XB_TOP      3328
#define XB_TOPGEN   3392
#define XCD_BAR_WORDS 3456
#define XB_SPIN_CAP (1u << 18)

__device__ __forceinline__ unsigned xb_ld(unsigned* p)              { return __hip_atomic_load(p, __ATOMIC_RELAXED, __HIP_MEMORY_SCOPE_AGENT); }
__device__ __forceinline__ unsigned xb_add(unsigned* p, unsigned v) { return __hip_atomic_fetch_add(p, v, __ATOMIC_RELAXED, __HIP_MEMORY_SCOPE_AGENT); }
__device__ __forceinline__ unsigned xb_xcc_id() { return (unsigned)__builtin_amdgcn_s_getreg((3 << 11) | 20) & 0xFu; }
#define XB_SPIN(cond, bar) do { unsigned _sp = 0; while (cond) { __builtin_amdgcn_s_sleep(1); \
    if ((++_sp & 255u) == 0u) { if (xb_ld(&(bar)[XB_TMO])) break; if (_sp > XB_SPIN_CAP) { atomicAdd(&(bar)[XB_TMO], 1u); break; } } } } while (0)

struct XcdBarrier {
    unsigned* bar; unsigned x;
    volatile __attribute__((address_space(3))) unsigned* st;
};

__device__ __forceinline__ XcdBarrier xcd_barrier_post(unsigned* bar, volatile __attribute__((address_space(3))) unsigned* st) {
    XcdBarrier b; b.bar = bar; b.x = xb_xcc_id(); b.st = st;
    if (threadIdx.x == 0) (void)xb_add(&bar[XB_XCNT(b.x)], 1u);
    return b;
}
__device__ __forceinline__ void xcd_barrier_complete(unsigned* bar, unsigned x, unsigned& nloc, unsigned& nx) {
    const unsigned G = gridDim.x * gridDim.y * gridDim.z;
    unsigned sum, cnt, mine, sp = 0u;
    for (;;) {
        sum = 0u; cnt = 0u; mine = 0u;
#pragma unroll
        for (unsigned j = 0; j < 16; ++j) { const unsigned c = xb_ld(&bar[XB_XCNT(j)]); sum += c; cnt += (c > 0u) ? 1u : 0u; mine = (j == x) ? c : mine; }
        if (sum == G) break;
        __builtin_amdgcn_s_sleep(1);
        if ((++sp & 255u) == 0u) { if (xb_ld(&bar[XB_TMO])) break; if (sp > XB_SPIN_CAP) { atomicAdd(&bar[XB_TMO], 1u); break; } }
    }
    nloc = mine > 0u ? mine : 1u; nx = cnt > 0u ? cnt : 1u;
}

__device__ __forceinline__ void xcd_barrier(const XcdBarrier& b) {
    asm volatile("s_waitcnt vmcnt(0)" ::: "memory");
    __syncthreads();
    if (threadIdx.x == 0) {
        unsigned* bar = b.bar;
        __builtin_amdgcn_s_waitcnt(0);
        unsigned nloc = b.st[0], nx = b.st[1];
        if (nloc == 0u) { xcd_barrier_complete(bar, b.x, nloc, nx); b.st[0] = nloc; b.st[1] = nx; }
        const unsigned old = xb_add(&bar[XB_XSUB(b.x)], 1u);
        const unsigned gen = old / nloc;
        if (old + 1u == (gen + 1u) * nloc) {
            __builtin_amdgcn_fence(__ATOMIC_RELEASE, "agent");
            asm volatile("s_waitcnt vmcnt(0)" ::: "memory");
            const unsigned og = xb_add(&bar[XB_TOP], 1u);
            const unsigned tg = og / nx;
            if (og + 1u == (tg + 1u) * nx) xb_add(&bar[XB_TOPGEN], 1u);
            else XB_SPIN(xb_ld(&bar[XB_TOPGEN]) == tg, bar);
            __builtin_amdgcn_fence(__ATOMIC_ACQUIRE, "agent");
            xb_add(&bar[XB_XGEN(b.x)], 1u);
            asm volatile("s_waitcnt vmcnt(0)" ::: "memory");
        } else {
            XB_SPIN(xb_ld(&bar[XB_XGEN(b.x)]) == gen, bar);
            __builtin_amdgcn_fence(__ATOMIC_ACQUIRE, "agent");
            asm volatile("s_waitcnt vmcnt(0)" ::: "memory");
        }
    }
    __syncthreads();
}

__global__ void __launch_bounds__(512, 2) fwd(Args a) {
    extern __shared__ __attribute__((aligned(16))) unsigned char lds_raw[];
    LAS unsigned char* lds = (LAS unsigned char*)lds_raw;
    cg::grid_group grid = cg::this_grid();
    const int G = gridDim.x, bx = blockIdx.x, vcu = (G % 8 == 0) ? (bx % 8) * (G / 8) + bx / 8 : bx;
    unsigned char* ws = a.ws;
    bf16_t* Wb = (bf16_t*)(ws + WS_W); bf16_t* XBF = (bf16_t*)(ws + WS_XBF); float* RS = (float*)(ws + WS_RS);
    bf16_t* Ub = (bf16_t*)(ws + WS_U); bf16_t* Qb = (bf16_t*)(ws + WS_Q); bf16_t* Kb = (bf16_t*)(ws + WS_K); bf16_t* Vb = (bf16_t*)(ws + WS_V);
    bf16_t* Gb = (bf16_t*)(ws + WS_G); bf16_t* YP = (bf16_t*)a.out;
    bf16_t* WCOMB = (bf16_t*)(ws + WS_YP);     bf16_t* MRG = (bf16_t*)(ws + WS_MRG); bf16_t* Hb = (bf16_t*)(ws + WS_H);
    unsigned* barw = (unsigned*)ws + 4096;
    if (bx == 0) for (int i = threadIdx.x; i < XCD_BAR_WORDS; i += 512) barw[i] = 0u;
    volatile LAS unsigned* bst = (volatile LAS unsigned*)(lds + 135168);
    if (threadIdx.x < 2) bst[threadIdx.x] = 0u;
    __syncthreads();
    XcdBarrier xbar; xbar.bar = barw; xbar.x = 0; xbar.st = bst;
#define SEAM() xcd_barrier(xbar)
    for (int l = 0; l < DEPTH; ++l) {
#if PHM & 1
        p0_phase(a, l, lds, vcu, G);
#if PROBE_DUP == 1
        grid.sync(); p0_phase(a, l, lds, vcu, G);
#endif
#endif
        if (l == 0) { grid.sync(); xbar = xcd_barrier_post(barw, bst); } else SEAM();
#if PHM & 2
        {
            pg8::Gemm g{XBF, Wb + WO_CAT, M_, NCAT, 1024}; pg8::StaticOrder S; S.init(M_, NCAT, G, bx);
            EpiIn E{Ub, Qb, Kb, Vb, Gb, RS, a.in[5] + l * 64, a.in[6] + l * 64, a.in[12] + (size_t)l * NGATE};
            pg8::gemm_phase<EpiIn, pg8::StaticOrder, true, true>(lds, g, S, E);
#if PROBE_DUP == 2
            grid.sync(); pg8::gemm_phase<EpiIn, pg8::StaticOrder, true, true>(lds, g, S, E);
#endif
        }
#endif
        SEAM();
#if PHM & 4
        mix_phase(Ub, YP, vcu, G);
#if PROBE_DUP == 3
        grid.sync(); mix_phase(Ub, YP, vcu, G);
#endif
#endif
#if PHM & 8
#if PROBE_DUP == 4
        attn_phase(a, l, lds, bx, 1, a.ws == nullptr); grid.sync();
#endif
        attn_phase(a, l, lds, bx);
#endif
        SEAM();
#if PHM & 16
        {
            pg8::StaticOrder S; S.init(M_, 1024, G, bx);
            { pg8::Gemm g{YP, WCOMB, M_, 1024, 1024, 512}; EpiMerge2 E{Gb, MRG}; pg8::gemm_phase2<EpiMerge2, pg8::StaticOrder, true, true>(lds, g, Qb, Wb + WO_BA, 1024, S, E); }
        }
#endif
        SEAM();
#if PHM & 32
        {
            pg8::Gemm g{MRG, Wb + WO_OUT, M_, 1024, 1024}; pg8::StaticOrder S; S.init(M_, 1024, G, bx);
            EpiResid E{a.out, XBF, RS, 1};
            pg8::gemm_phase<EpiResid, pg8::StaticOrder, true, true>(lds, g, S, E);
        }
        SEAM();
#endif
#if PHM & 64
        {
            pg8::Gemm g{XBF, Wb + WO_UP, M_, FF, 1024}; pg8::StaticOrder S; S.init(M_, FF, G, bx);
            EpiUp E{Hb, RS};
            pg8::gemm_phase<EpiUp, pg8::StaticOrder, true, true>(lds, g, S, E);
#if PROBE_DUP == 6
            grid.sync(); pg8::gemm_phase<EpiUp, pg8::StaticOrder, true, true>(lds, g, S, E);
#endif
        }
        SEAM();
#endif
#if PHM & 128
        {
            pg8::Gemm g{Hb, Wb + WO_DOWN, M_, 1024, FF}; pg8::StaticOrder S; S.init(M_, 1024, G, bx);
            EpiResid E{a.out, XBF, RS, l + 1 < DEPTH ? 1 : 0};
            pg8::gemm_phase<EpiResid, pg8::StaticOrder, true, true>(lds, g, S, E);
        }
#endif
        if (l + 1 < DEPTH) SEAM();
#if PROBE_DUP == 7
        for (int i = 0; i < 10; ++i) SEAM();
#endif
    }
}
}

extern "C" void kernel_launch(void* const* d_in, const int* in_sizes, int n_in, void* d_out, int out_size, void* d_ws, size_t ws_size, hipStream_t stream) {
    static int grid = 0;
    if (grid == 0) {
        if (n_in != 17 || out_size != mk::M_ * mk::D_ || ws_size < mk::WS_END) { fprintf(stderr, "kernel_launch: unexpected shapes (n_in %d, out %d, ws %zu)\n", n_in, out_size, ws_size); grid = -1; return; }
        int dev = 0, cus = 0, per_cu = 0;
        hipGetDevice(&dev);
        hipDeviceGetAttribute(&cus, hipDeviceAttributeMultiprocessorCount, dev);
        if (hipFuncSetAttribute((const void*)mk::fwd, hipFuncAttributeMaxDynamicSharedMemorySize, mk::LDS_BYTES) != hipSuccess) { fprintf(stderr, "kernel_launch: hipFuncSetAttribute failed\n"); grid = -1; return; }
        hipOccupancyMaxActiveBlocksPerMultiprocessor(&per_cu, (const void*)mk::fwd, 512, mk::LDS_BYTES);
        if (per_cu < 1) { fprintf(stderr, "kernel_launch: occupancy query says 0 blocks per CU\n"); per_cu = 1; }
        (void)hipGetLastError();
        grid = cus;
    }
    if (grid < 0) return;
    mk::Args a{};
    for (int i = 0; i < 17; ++i) a.in[i] = (const float*)d_in[i];
    a.out = (float*)d_out; a.ws = (unsigned char*)d_ws;
    void* args[] = {&a};
    hipError_t e = hipLaunchCooperativeKernel((void*)mk::fwd, dim3(grid), dim3(512), args, mk::LDS_BYTES, stream);
    if (e != hipSuccess) fprintf(stderr, "kernel_launch: cooperative launch failed: %s (grid %d)\n", hipGetErrorString(e), grid);
}
```

```cpp
#include <hip/hip_runtime.h>
#include <hip/hip_cooperative_groups.h>
#include <cstdio>
#include <cstdint>
namespace cg = cooperative_groups;
namespace pg8 {
#define PG8_LAS __attribute__((address_space(3)))
typedef unsigned short bf16_t;
typedef short bf16x8 __attribute__((ext_vector_type(8)));
typedef float f32x4 __attribute__((ext_vector_type(4)));
typedef unsigned u32x4 __attribute__((ext_vector_type(4)));
constexpr int BM = 256, BK = 64, HALF = 128, HTB = HALF * BK * 2  , STAGE_BYTES = 8 * HTB, NXCD = 8, WGM = 8;

__host__ __device__ __forceinline__ int lds_byte(int r, int c) { const int st = (r >> 4) * 2 + (c >> 5), rr = r & 15, cc = c & 31, ob = rr * 64 + cc * 2; return st * 1024 + (ob ^ (((ob >> 9) & 1) << 5)); }
__host__ __device__ __forceinline__ void stage_rc(int b, int& R, int& C) { const int st = b / 1024, sb = b % 1024, swz = sb ^ (((sb >> 9) & 1) << 5); R = (st >> 1) * 16 + swz / 64; C = (st & 1) * 32 + (swz % 64) / 2; }
__host__ __device__ __forceinline__ int perm32(int rho) { const int n = rho >> 4, i = rho & 15; return 8 * (i >> 2) + 4 * n + (i & 3); }

struct Unit { int pm, pn; };
struct Gemm { const bf16_t* A; const bf16_t* Bt; int M, N, K; int N_seg0K = 0; };

struct StaticOrder {
    int nM, nN, nwg, G, c;
    __host__ __device__ void init(int M, int N, int G_, int c_) { nM = M / BM; nN = N / BM; nwg = nM * nN; G = G_; c = c_; }
    __host__ __device__ bool next(int i, Unit& u) const {
        const long L = (long)i * G + c; if (L >= nwg) return false;
        int wgid = (int)L; { const int q = nwg / NXCD, r = nwg % NXCD, xcd = wgid % NXCD, off = wgid / NXCD; wgid = (xcd < r ? xcd * (q + 1) : r * (q + 1) + (xcd - r) * q) + off; }
        const int nig = WGM * nN, gid = wgid / nig, fm = gid * WGM, gsz = (nM - fm) < WGM ? (nM - fm) : WGM;
        u.pm = fm + ((wgid % nig) % gsz); u.pn = (wgid % nig) / gsz; return true;
    }
    __device__ __forceinline__ void a_ready(const Unit&) const {}
    __device__ __forceinline__ void done(const Unit&) const {}
};
__device__ __forceinline__ unsigned cvt_pk_bf16(float lo, float hi) { unsigned r; asm volatile("v_cvt_pk_bf16_f32 %0, %1, %2" : "=v"(r) : "v"(lo), "v"(hi)); return r; }
typedef float f32x2 __attribute__((ext_vector_type(2)));
template <class Epi, class Sched, bool ALIGN_EPI = false, bool SP2 = false>
__device__ __forceinline__ void gemm_phase(PG8_LAS unsigned char* lds, const Gemm g, const Sched& S, const Epi& E) {
    int tid_ = threadIdx.x; asm volatile("" : "+v"(tid_));
    const int tid = tid_, wid = __builtin_amdgcn_readfirstlane(tid >> 6), lane = tid & 63, wr = wid >> 2, wc = wid & 3, fr = lane & 15, fq = lane >> 4;
    const int K = g.K, nt = K / BK;
    unsigned voffA[2], voffB[2];
#pragma unroll
    for (int i = 0; i < 2; ++i) { int R, C; stage_rc(tid * 16 + i * 8192, R, C); const int Rb = Epi::PERM ? ((R & ~31) + perm32(R & 31)) : R;
        voffA[i] = (unsigned)(R * K + C) * 2u; voffB[i] = (unsigned)(Rb * K + C) * 2u; }
    const size_t kstep = (size_t)(BK * 2);
    const size_t hstep = (size_t)HALF * K * 2;
    const size_t tstep = 2 * hstep;
    const unsigned ldsw = (unsigned)wid * 1024u;
    const int aoff = lds_byte(wr * 64 + fr, fq * 8), boff = lds_byte(wc * 32 + fr, fq * 8);
#define PG8_SA(b, h) (((b) * 2 + (h)) * HTB)
#define PG8_SB(b, h) ((4 + (b) * 2 + (h)) * HTB)
#define PG8_STAGE(bufoff, gbase, voff) do { _Pragma("unroll") for (int _i = 0; _i < 2; ++_i) \
        __builtin_amdgcn_global_load_lds((const unsigned*)((const char*)(gbase) + (voff)[_i]), (PG8_LAS unsigned*)(lds + (bufoff) + ldsw + _i * 8192), 16, 0, 0); } while (0)
#define PG8_LDA(dst, b, h) do { _Pragma("unroll") for (int m = 0; m < 4; ++m) _Pragma("unroll") for (int k = 0; k < 2; ++k) dst[m][k] = *(const PG8_LAS bf16x8*)(lds + PG8_SA(b, h) + aoff + m * 2048 + k * 1024); } while (0)
#define PG8_LDB(dst, b, h) do { _Pragma("unroll") for (int n = 0; n < 2; ++n) _Pragma("unroll") for (int k = 0; k < 2; ++k) dst[n][k] = *(const PG8_LAS bf16x8*)(lds + PG8_SB(b, h) + boff + n * 2048 + k * 1024); } while (0)
#define PG8_MMA(ai, bj, At, Bt) do { __builtin_amdgcn_s_setprio(1); _Pragma("unroll") for (int m = 0; m < 4; ++m) _Pragma("unroll") for (int n = 0; n < 2; ++n) _Pragma("unroll") for (int k = 0; k < 2; ++k) \
        acc[ai][bj][m][n] = __builtin_amdgcn_mfma_f32_16x16x32_bf16(Bt[n][k], At[m][k], acc[ai][bj][m][n], 0, 0, 0); __builtin_amdgcn_s_setprio(0); } while (0)
#define PG8_WAIT_V(n) asm volatile("s_waitcnt vmcnt(" #n ")" ::: "memory")
#define PG8_WAIT_L(n) asm volatile("s_waitcnt lgkmcnt(" #n ")" ::: "memory")
#define PG8_BAR __builtin_amdgcn_s_barrier()
#define PG8_SCHED __builtin_amdgcn_sched_barrier(0)
    Unit cur, nxt; int ui = 0;
    if (!S.next(0, cur)) return;
    f32x4 acc[2][2][4][2];
#pragma unroll
    for (int a = 0; a < 2; ++a)
#pragma unroll
        for (int b = 0; b < 2; ++b)
#pragma unroll
            for (int m = 0; m < 4; ++m)
#pragma unroll
                for (int n = 0; n < 2; ++n) acc[a][b][m][n] = (f32x4){0.f, 0.f, 0.f, 0.f};
    bf16x8 At[4][2], B0[2][2], B1[2][2];
    const char* cA = (const char*)g.A + (size_t)cur.pm * tstep; const char* cB = (const char*)g.Bt + (size_t)cur.pn * tstep;
    S.a_ready(cur);
    if constexpr (SP2) {
        PG8_STAGE(PG8_SB(0, 0), cB, voffB); PG8_STAGE(PG8_SB(0, 1), cB + hstep, voffB); PG8_STAGE(PG8_SA(0, 0), cA, voffA); PG8_STAGE(PG8_SA(0, 1), cA + hstep, voffA);
        if (wr == 1) PG8_BAR;
        PG8_WAIT_V(2); PG8_BAR;
        PG8_STAGE(PG8_SB(1, 0), cB + kstep, voffB); PG8_STAGE(PG8_SA(1, 0), cA + kstep, voffA); PG8_STAGE(PG8_SB(1, 1), cB + hstep + kstep, voffB);
        PG8_WAIT_V(6); PG8_BAR;
    } else {
        PG8_STAGE(PG8_SB(0, 0), cB, voffB); PG8_STAGE(PG8_SA(0, 0), cA, voffA); PG8_STAGE(PG8_SB(0, 1), cB + hstep, voffB); PG8_STAGE(PG8_SA(0, 1), cA + hstep, voffA);
        if (wr == 1) PG8_BAR;
        PG8_WAIT_V(4); PG8_BAR;
        PG8_STAGE(PG8_SB(1, 0), cB + kstep, voffB); PG8_STAGE(PG8_SA(1, 0), cA + kstep, voffA); PG8_STAGE(PG8_SB(1, 1), cB + hstep + kstep, voffB);
        PG8_WAIT_V(6); PG8_BAR;
    }
    for (;;) {
        const bool has_next = S.next(ui + 1, nxt);
        const char* nA = has_next ? (const char*)g.A + (size_t)nxt.pm * tstep : cA; const char* nB = has_next ? (const char*)g.Bt + (size_t)nxt.pn * tstep : cB;
        for (int t = 0; t < nt; t += 2) {
            const bool last = (t == nt - 2);
            const char* a1 = cA + (size_t)(t + 1) * kstep;
            const char* a2 = last ? nA : cA + (size_t)(t + 2) * kstep; const char* b2 = last ? nB : cB + (size_t)(t + 2) * kstep;
            const char* a3 = a2 + kstep; const char* b3 = b2 + kstep;
            if (last && has_next) S.a_ready(nxt);
            if constexpr (SP2) {
            PG8_LDB(B0, 0, 0); PG8_LDB(B1, 0, 1); PG8_SCHED; PG8_LDA(At, 0, 0); PG8_STAGE(PG8_SA(1, 1), a1 + hstep, voffA);
            PG8_WAIT_V(8); PG8_WAIT_L(0); PG8_BAR; PG8_MMA(0, 0, At, B0); PG8_MMA(0, 1, At, B1); PG8_BAR; PG8_SCHED;
            PG8_LDA(At, 0, 1); PG8_STAGE(PG8_SB(0, 0), b2, voffB); PG8_STAGE(PG8_SB(0, 1), b2 + hstep, voffB); PG8_STAGE(PG8_SA(0, 0), a2, voffA);
            PG8_WAIT_V(8); PG8_WAIT_L(0); PG8_BAR; PG8_MMA(1, 0, At, B0); PG8_MMA(1, 1, At, B1); PG8_BAR; PG8_SCHED;
            PG8_LDB(B0, 1, 0); PG8_LDB(B1, 1, 1); PG8_SCHED; PG8_LDA(At, 1, 0); PG8_STAGE(PG8_SA(0, 1), a2 + hstep, voffA);
            PG8_WAIT_V(8); PG8_WAIT_L(0); PG8_BAR; PG8_MMA(0, 0, At, B0); PG8_MMA(0, 1, At, B1); PG8_BAR; PG8_SCHED;
            PG8_LDA(At, 1, 1); PG8_STAGE(PG8_SB(1, 0), b3, voffB); PG8_STAGE(PG8_SB(1, 1), b3 + hstep, voffB); PG8_STAGE(PG8_SA(1, 0), a3, voffA);
            PG8_WAIT_V(8); PG8_WAIT_L(0); PG8_BAR; PG8_MMA(1, 0, At, B0); PG8_MMA(1, 1, At, B1); PG8_BAR; PG8_SCHED;
            } else {
            PG8_LDB(B0, 0, 0); PG8_SCHED; PG8_LDA(At, 0, 0); PG8_STAGE(PG8_SA(1, 1), a1 + hstep, voffA);
            PG8_WAIT_L(8); PG8_BAR; PG8_WAIT_L(0); PG8_MMA(0, 0, At, B0); PG8_BAR; PG8_SCHED;
            PG8_LDB(B1, 0, 1); PG8_STAGE(PG8_SB(0, 0), b2, voffB);
            PG8_BAR; PG8_WAIT_L(0); PG8_MMA(0, 1, At, B1); PG8_BAR;
            PG8_LDA(At, 0, 1); PG8_STAGE(PG8_SA(0, 0), a2, voffA);
            PG8_BAR; PG8_WAIT_L(0); PG8_MMA(1, 0, At, B0); PG8_BAR; PG8_SCHED;
            PG8_STAGE(PG8_SB(0, 1), b2 + hstep, voffB);
            PG8_WAIT_V(6); PG8_BAR; PG8_MMA(1, 1, At, B1); PG8_BAR;
            PG8_LDB(B0, 1, 0); PG8_SCHED; PG8_LDA(At, 1, 0); PG8_STAGE(PG8_SA(0, 1), a2 + hstep, voffA);
            PG8_WAIT_L(8); PG8_BAR; PG8_WAIT_L(0); PG8_MMA(0, 0, At, B0); PG8_BAR; PG8_SCHED;
            PG8_LDB(B1, 1, 1); PG8_STAGE(PG8_SB(1, 0), b3, voffB);
            PG8_BAR; PG8_WAIT_L(0); PG8_MMA(0, 1, At, B1); PG8_BAR;
            PG8_LDA(At, 1, 1); PG8_STAGE(PG8_SA(1, 0), a3, voffA);
            PG8_BAR; PG8_WAIT_L(0); PG8_MMA(1, 0, At, B0); PG8_BAR; PG8_SCHED;
            PG8_STAGE(PG8_SB(1, 1), b3 + hstep, voffB);
            PG8_WAIT_V(6); PG8_BAR; PG8_MMA(1, 1, At, B1); PG8_BAR;
            }
        }
        if constexpr (ALIGN_EPI) { if (wr == 0) PG8_BAR; }
        if constexpr (!Epi::AFTER_DRAIN) { E(acc, cur, wr, wc, fr, fq); S.done(cur); }
        if (!has_next) break;
#pragma unroll
        for (int a = 0; a < 2; ++a)
#pragma unroll
            for (int b = 0; b < 2; ++b)
#pragma unroll
                for (int m = 0; m < 4; ++m)
#pragma unroll
                    for (int n = 0; n < 2; ++n) acc[a][b][m][n] = (f32x4){0.f, 0.f, 0.f, 0.f};
        cur = nxt; cA = nA; cB = nB; ++ui;
        if constexpr (ALIGN_EPI) { if (wr == 1) PG8_BAR; }
    }
    PG8_WAIT_V(0);
    if constexpr (!ALIGN_EPI) { if (wr == 0) PG8_BAR; }
    PG8_BAR;
    if constexpr (Epi::AFTER_DRAIN) { E.fused(acc, cur, wr, wc, fr, fq, lds, wid, lane); S.done(cur); }
}
template <class Epi, class Sched, bool ALIGN_EPI = false, bool SP2 = false>
__device__ __forceinline__ void gemm_phase2(PG8_LAS unsigned char* lds, const Gemm g, const bf16_t* A1, const bf16_t* Bt1, int K1, const Sched& S, const Epi& E) {
    int tid_ = threadIdx.x; asm volatile("" : "+v"(tid_));
    const int tid = tid_, wid = __builtin_amdgcn_readfirstlane(tid >> 6), lane = tid & 63, wr = wid >> 2, wc = wid & 3, fr = lane & 15, fq = lane >> 4;
    const int K = g.K  , nt0 = g.N_seg0K / BK, nt1 = K1 / BK;
    unsigned voffA[2], voffB[2];
#pragma unroll
    for (int i = 0; i < 2; ++i) { int R, C; stage_rc(tid * 16 + i * 8192, R, C); const int Rb = Epi::PERM ? ((R & ~31) + perm32(R & 31)) : R;
        voffA[i] = (unsigned)(R * K + C) * 2u; voffB[i] = (unsigned)(Rb * K + C) * 2u; }
    const size_t kstep = (size_t)(BK * 2);
    const size_t hstep = (size_t)HALF * K * 2;
    const size_t tstep = 2 * hstep;
    const unsigned ldsw = (unsigned)wid * 1024u;
    const int aoff = lds_byte(wr * 64 + fr, fq * 8), boff = lds_byte(wc * 32 + fr, fq * 8);
#define PG8_SA(b, h) (((b) * 2 + (h)) * HTB)
#define PG8_SB(b, h) ((4 + (b) * 2 + (h)) * HTB)
#define PG8_STAGE(bufoff, gbase, voff) do { _Pragma("unroll") for (int _i = 0; _i < 2; ++_i) \
        __builtin_amdgcn_global_load_lds((const unsigned*)((const char*)(gbase) + (voff)[_i]), (PG8_LAS unsigned*)(lds + (bufoff) + ldsw + _i * 8192), 16, 0, 0); } while (0)
#define PG8_LDA(dst, b, h) do { _Pragma("unroll") for (int m = 0; m < 4; ++m) _Pragma("unroll") for (int k = 0; k < 2; ++k) dst[m][k] = *(const PG8_LAS bf16x8*)(lds + PG8_SA(b, h) + aoff + m * 2048 + k * 1024); } while (0)
#define PG8_LDB(dst, b, h) do { _Pragma("unroll") for (int n = 0; n < 2; ++n) _Pragma("unroll") for (int k = 0; k < 2; ++k) dst[n][k] = *(const PG8_LAS bf16x8*)(lds + PG8_SB(b, h) + boff + n * 2048 + k * 1024); } while (0)
#define PG8_MMA(ai, bj, At, Bt) do { __builtin_amdgcn_s_setprio(1); _Pragma("unroll") for (int m = 0; m < 4; ++m) _Pragma("unroll") for (int n = 0; n < 2; ++n) _Pragma("unroll") for (int k = 0; k < 2; ++k) \
        acc[ai][bj][m][n] = __builtin_amdgcn_mfma_f32_16x16x32_bf16(Bt[n][k], At[m][k], acc[ai][bj][m][n], 0, 0, 0); __builtin_amdgcn_s_setprio(0); } while (0)
#define PG8_WAIT_V(n) asm volatile("s_waitcnt vmcnt(" #n ")" ::: "memory")
#define PG8_WAIT_L(n) asm volatile("s_waitcnt lgkmcnt(" #n ")" ::: "memory")
#define PG8_BAR __builtin_amdgcn_s_barrier()
#define PG8_SCHED __builtin_amdgcn_sched_barrier(0)
    Unit cur, nxt; int ui = 0; int cseg = 0;
    if (!S.next(0, cur)) return;
    f32x4 acc[2][2][4][2];
#pragma unroll
    for (int a = 0; a < 2; ++a)
#pragma unroll
        for (int b = 0; b < 2; ++b)
#pragma unroll
            for (int m = 0; m < 4; ++m)
#pragma unroll
                for (int n = 0; n < 2; ++n) acc[a][b][m][n] = (f32x4){0.f, 0.f, 0.f, 0.f};
    bf16x8 At[4][2], B0[2][2], B1[2][2];
    const char* cA = (const char*)g.A + (size_t)cur.pm * tstep; const char* cB = (const char*)g.Bt + (size_t)cur.pn * tstep;
    if constexpr (SP2) {
        PG8_STAGE(PG8_SB(0, 0), cB, voffB); PG8_STAGE(PG8_SB(0, 1), cB + hstep, voffB); PG8_STAGE(PG8_SA(0, 0), cA, voffA); PG8_STAGE(PG8_SA(0, 1), cA + hstep, voffA);
        if (wr == 1) PG8_BAR;
        PG8_WAIT_V(2); PG8_BAR;
        PG8_STAGE(PG8_SB(1, 0), cB + kstep, voffB); PG8_STAGE(PG8_SA(1, 0), cA + kstep, voffA); PG8_STAGE(PG8_SB(1, 1), cB + hstep + kstep, voffB);
        PG8_WAIT_V(6); PG8_BAR;
    } else {
        PG8_STAGE(PG8_SB(0, 0), cB, voffB); PG8_STAGE(PG8_SA(0, 0), cA, voffA); PG8_STAGE(PG8_SB(0, 1), cB + hstep, voffB); PG8_STAGE(PG8_SA(0, 1), cA + hstep, voffA);
        if (wr == 1) PG8_BAR;
        PG8_WAIT_V(4); PG8_BAR;
        PG8_STAGE(PG8_SB(1, 0), cB + kstep, voffB); PG8_STAGE(PG8_SA(1, 0), cA + kstep, voffA); PG8_STAGE(PG8_SB(1, 1), cB + hstep + kstep, voffB);
        PG8_WAIT_V(6); PG8_BAR;
    }
    for (;;) {
        const int nseg = cseg ^ 1; bool has_next; if (cseg == 0) { nxt = cur; has_next = true; } else has_next = S.next((ui >> 1) + 1, nxt);
        const int nt = cseg ? nt1 : nt0;
        const char* nA = has_next ? (const char*)(nseg ? A1 : g.A) + (size_t)nxt.pm * tstep : cA; const char* nB = has_next ? (const char*)(nseg ? Bt1 : g.Bt) + (size_t)nxt.pn * tstep : cB;
        for (int t = 0; t < nt; t += 2) {
            const bool last = (t == nt - 2);
            const char* a1 = cA + (size_t)(t + 1) * kstep;
            const char* a2 = last ? nA : cA + (size_t)(t + 2) * kstep; const char* b2 = last ? nB : cB + (size_t)(t + 2) * kstep;
            const char* a3 = a2 + kstep; const char* b3 = b2 + kstep;
            if constexpr (SP2) {
            PG8_LDB(B0, 0, 0); PG8_LDB(B1, 0, 1); PG8_SCHED; PG8_LDA(At, 0, 0); PG8_STAGE(PG8_SA(1, 1), a1 + hstep, voffA);
            PG8_WAIT_V(8); PG8_WAIT_L(0); PG8_BAR; PG8_MMA(0, 0, At, B0); PG8_MMA(0, 1, At, B1); PG8_BAR; PG8_SCHED;
            PG8_LDA(At, 0, 1); PG8_STAGE(PG8_SB(0, 0), b2, voffB); PG8_STAGE(PG8_SB(0, 1), b2 + hstep, voffB); PG8_STAGE(PG8_SA(0, 0), a2, voffA);
            PG8_WAIT_V(8); PG8_WAIT_L(0); PG8_BAR; PG8_MMA(1, 0, At, B0); PG8_MMA(1, 1, At, B1); PG8_BAR; PG8_SCHED;
            PG8_LDB(B0, 1, 0); PG8_LDB(B1, 1, 1); PG8_SCHED; PG8_LDA(At, 1, 0); PG8_STAGE(PG8_SA(0, 1), a2 + hstep, voffA);
            PG8_WAIT_V(8); PG8_WAIT_L(0); PG8_BAR; PG8_MMA(0, 0, At, B0); PG8_MMA(0, 1, At, B1); PG8_BAR; PG8_SCHED;
            PG8_LDA(At, 1, 1); PG8_STAGE(PG8_SB(1, 0), b3, voffB); PG8_STAGE(PG8_SB(1, 1), b3 + hstep, voffB); PG8_STAGE(PG8_SA(1, 0), a3, voffA);
            PG8_WAIT_V(8); PG8_WAIT_L(0); PG8_BAR; PG8_MMA(1, 0, At, B0); PG8_MMA(1, 1, At, B1); PG8_BAR; PG8_SCHED;
            } else {
            PG8_LDB(B0, 0, 0); PG8_SCHED; PG8_LDA(At, 0, 0); PG8_STAGE(PG8_SA(1, 1), a1 + hstep, voffA);
            PG8_WAIT_L(8); PG8_BAR; PG8_WAIT_L(0); PG8_MMA(0, 0, At, B0); PG8_BAR; PG8_SCHED;
            PG8_LDB(B1, 0, 1); PG8_STAGE(PG8_SB(0, 0), b2, voffB);
            PG8_BAR; PG8_WAIT_L(0); PG8_MMA(0, 1, At, B1); PG8_BAR;
            PG8_LDA(At, 0, 1); PG8_STAGE(PG8_SA(0, 0), a2, voffA);
            PG8_BAR; PG8_WAIT_L(0); PG8_MMA(1, 0, At, B0); PG8_BAR; PG8_SCHED;
            PG8_STAGE(PG8_SB(0, 1), b2 + hstep, voffB);
            PG8_WAIT_V(6); PG8_BAR; PG8_MMA(1, 1, At, B1); PG8_BAR;
            PG8_LDB(B0, 1, 0); PG8_SCHED; PG8_LDA(At, 1, 0); PG8_STAGE(PG8_SA(0, 1), a2 + hstep, voffA);
            PG8_WAIT_L(8); PG8_BAR; PG8_WAIT_L(0); PG8_MMA(0, 0, At, B0); PG8_BAR; PG8_SCHED;
            PG8_LDB(B1, 1, 1); PG8_STAGE(PG8_SB(1, 0), b3, voffB);
            PG8_BAR; PG8_WAIT_L(0); PG8_MMA(0, 1, At, B1); PG8_BAR;
            PG8_LDA(At, 1, 1); PG8_STAGE(PG8_SA(1, 0), a3, voffA);
            PG8_BAR; PG8_WAIT_L(0); PG8_MMA(1, 0, At, B0); PG8_BAR; PG8_SCHED;
            PG8_STAGE(PG8_SB(1, 1), b3 + hstep, voffB);
            PG8_WAIT_V(6); PG8_BAR; PG8_MMA(1, 1, At, B1); PG8_BAR;
            }
        }
        if constexpr (ALIGN_EPI) { if (wr == 0) PG8_BAR; }
        if (cseg == 0) E.mid(acc, cur, wr, wc, fr, fq); else E(acc, cur, wr, wc, fr, fq);
        if (!has_next) break;
        if (cseg == 1) {
#pragma unroll
        for (int a = 0; a < 2; ++a)
#pragma unroll
            for (int b = 0; b < 2; ++b)
#pragma unroll
                for (int m = 0; m < 4; ++m)
#pragma unroll
                    for (int n = 0; n < 2; ++n) acc[a][b][m][n] = (f32x4){0.f, 0.f, 0.f, 0.f};
        }
        cur = nxt; cA = nA; cB = nB; ++ui; cseg = nseg;
        if constexpr (ALIGN_EPI) { if (wr == 1) PG8_BAR; }
    }
    PG8_WAIT_V(0);
    if constexpr (!ALIGN_EPI) { if (wr == 0) PG8_BAR; }
    PG8_BAR;
#undef PG8_SA
#undef PG8_SB
#undef PG8_STAGE
#undef PG8_LDA
#undef PG8_LDB
#undef PG8_MMA
#undef PG8_WAIT_V
#undef PG8_WAIT_L
#undef PG8_BAR
#undef PG8_SCHED
}
}
#ifndef PHM
#define PHM 255
#endif
#ifndef PROBE_DUP
#define PROBE_DUP 0
#endif
namespace mk {
__device__ __forceinline__ int fresh_tid() { int t = threadIdx.x; asm volatile("" : "+v"(t)); return t; }
using pg8::bf16_t; using pg8::f32x4; using pg8::u32x4; using pg8::Unit;
#define LAS __attribute__((address_space(3)))
typedef short bf16x8 __attribute__((ext_vector_type(8)));
typedef float f32x16 __attribute__((ext_vector_type(16)));
typedef short s16x4 __attribute__((ext_vector_type(4)));
typedef short v4i16_t __attribute__((ext_vector_type(4)));

constexpr int NB = 8, S_ = 4096, D_ = 1024, M_ = NB * S_, IN_ = 3584, NGATE = 2048, NCAT = IN_ + NGATE, FF = 4096, POOL = 512, DEPTH = 2;
constexpr float EPS = 1e-6f, LOG2E = 1.4426950408889634f;
constexpr size_t MiB = 1u << 20;
constexpr size_t WS_RS = 1 * MiB;
constexpr size_t WS_W = 3 * MiB;
constexpr size_t WO_CAT = 0, WO_COMB = (size_t)NCAT * 1024, WO_BA = WO_COMB + 1024 * 512, WO_OUT = WO_BA + 1024 * 1024, WO_UP = WO_OUT + 1024 * 1024, WO_DOWN = WO_UP + 4096 * 1024;
constexpr size_t WS_XBF = 35 * MiB;
constexpr size_t WS_U = 99 * MiB;
constexpr size_t WS_Q = 131 * MiB;
constexpr size_t WS_K = 195 * MiB;
constexpr size_t WS_V = 259 * MiB;
constexpr size_t WS_G = 323 * MiB;
constexpr size_t WS_YP = 451 * MiB;
constexpr size_t WS_MRG = WS_K;
constexpr size_t WS_H = WS_U;
constexpr size_t WS_COMB1 = 453 * MiB, WS_W1 = 456 * MiB;
constexpr size_t WS_END = 488 * MiB;
constexpr int LDS_BYTES = 147456;

__device__ __forceinline__ unsigned pk2(float lo, float hi) { return pg8::cvt_pk_bf16(lo, hi); }
__device__ __forceinline__ float bflo(unsigned w) { return __uint_as_float(w << 16); }
__device__ __forceinline__ float bfhi(unsigned w) { return __uint_as_float(w & 0xffff0000u); }
__device__ __forceinline__ float wave_sum(float v) {
#pragma unroll
    for (int o = 1; o < 64; o <<= 1) v += __shfl_xor(v, o);
    return v;
}
__device__ __forceinline__ float wave_max(float v) {
#pragma unroll
    for (int o = 1; o < 64; o <<= 1) v = fmaxf(v, __shfl_xor(v, o));
    return v;
}
__device__ __forceinline__ float rstd_row(const float* RS, int row, int fq) {
    const f32x4 v = *(const f32x4*)(RS + (size_t)row * 16 + 4 * fq);
    float s = (v[0] + v[1]) + (v[2] + v[3]);
    s += __shfl_xor(s, 16); s += __shfl_xor(s, 32);
    return rsqrtf(s * (1.0f / 1024.0f) + EPS);
}
__device__ __forceinline__ float sigmoidf_(float z) { return __builtin_amdgcn_rcpf(1.0f + __builtin_amdgcn_exp2f(-z * LOG2E)); }

struct EpiIn {
    static constexpr bool PERM = true, AFTER_DRAIN = false;
    bf16_t *U, *Q, *K, *V, *G; const float* RS; const float* gq; const float* gk; const float* bgate;
    __device__ __forceinline__ void operator()(const f32x4 (&acc)[2][2][4][2], const Unit& u, int wr, int wc, int fr, int fq) const {
        const int row0 = u.pm * 256 + wr * 64 + fr, pn = u.pn;
        if (pn >= 2 && pn < 10) {
            const bool isq = pn < 6; bf16_t* base = isq ? Q : K; const int colt = (pn - (isq ? 2 : 6)) * 256 + 64 * wc + 8 * fq;
            const float* g = isq ? gq : gk; const float sc = isq ? 0.125f * LOG2E : 1.0f;
            f32x4 gv[2][2];
#pragma unroll
            for (int bj = 0; bj < 2; ++bj)
#pragma unroll
                for (int n = 0; n < 2; ++n) gv[bj][n] = *(const f32x4*)(g + 32 * bj + 8 * fq + 4 * n) * sc;
#pragma unroll
            for (int ai = 0; ai < 2; ++ai)
#pragma unroll
                for (int m = 0; m < 4; ++m) {
                    const int row = row0 + ai * 128 + m * 16; const float r = rstd_row(RS, row, fq);
                    f32x4 v[2][2]; float ss = 0.f;
#pragma unroll
                    for (int bj = 0; bj < 2; ++bj)
#pragma unroll
                        for (int n = 0; n < 2; ++n) { v[bj][n] = acc[ai][bj][m][n] * r; const f32x4 q = v[bj][n] * v[bj][n]; ss += (q[0] + q[1]) + (q[2] + q[3]); }
                    ss += __shfl_xor(ss, 16); ss += __shfl_xor(ss, 32);
                    const float rn = rsqrtf(ss * (1.0f / 64.0f) + EPS);
                    bf16_t* rowp = base + (size_t)row * 1024 + colt;
#pragma unroll
                    for (int bj = 0; bj < 2; ++bj) { const f32x4 v0 = v[bj][0] * rn * gv[bj][0], v1 = v[bj][1] * rn * gv[bj][1];
                        u32x4 w; w.x = pk2(v0[0], v0[1]); w.y = pk2(v0[2], v0[3]); w.z = pk2(v1[0], v1[1]); w.w = pk2(v1[2], v1[3]);
                        __builtin_nontemporal_store(w, (u32x4*)(rowp + 32 * bj)); }
                }
        } else {
            bf16_t* base; int ld, colt; bool sg = false;
            if (pn < 2) { base = U; ld = 512; colt = pn * 256; } else if (pn < 14) { base = V; ld = 1024; colt = (pn - 10) * 256; } else { base = G; ld = 2048; colt = (pn - 14) * 256; sg = true; }
            const int col0 = colt + wc * 32 + 8 * fq;
            f32x4 bv[2][2];
#pragma unroll
            for (int bj = 0; bj < 2; ++bj)
#pragma unroll
                for (int n = 0; n < 2; ++n) bv[bj][n] = sg ? *(const f32x4*)(bgate + col0 + bj * 128 + 4 * n) : (f32x4){0.f, 0.f, 0.f, 0.f};
#pragma unroll
            for (int ai = 0; ai < 2; ++ai)
#pragma unroll
                for (int m = 0; m < 4; ++m) {
                    const int row = row0 + ai * 128 + m * 16; const float r = rstd_row(RS, row, fq);
                    bf16_t* rowp = base + (size_t)row * ld + col0;
#pragma unroll
                    for (int bj = 0; bj < 2; ++bj) { f32x4 v0 = acc[ai][bj][m][0] * r + bv[bj][0], v1 = acc[ai][bj][m][1] * r + bv[bj][1];
                        if (sg) {
#pragma unroll
                            for (int i = 0; i < 4; ++i) { v0[i] = sigmoidf_(v0[i]); v1[i] = sigmoidf_(v1[i]); } }
                        u32x4 w; w.x = pk2(v0[0], v0[1]); w.y = pk2(v0[2], v0[3]); w.z = pk2(v1[0], v1[1]); w.w = pk2(v1[2], v1[3]);
                        __builtin_nontemporal_store(w, (u32x4*)(rowp + bj * 128)); }
                }
        }
    }
};
struct EpiMerge2 {
    static constexpr bool PERM = true, AFTER_DRAIN = false;
    const bf16_t* G; bf16_t* MRG;
    __device__ __forceinline__ void mid(f32x4 (&acc)[2][2][4][2], const Unit& u, int wr, int wc, int fr, int fq) const {
        const int row0 = u.pm * 256 + wr * 64 + fr, col0 = u.pn * 256 + wc * 32 + 8 * fq;
#pragma unroll
        for (int ai = 0; ai < 2; ++ai)
#pragma unroll
            for (int m = 0; m < 4; ++m) {
                const int row = row0 + ai * 128 + m * 16;
#pragma unroll
                for (int bj = 0; bj < 2; ++bj) {
                    const bf16_t* gp = G + (size_t)row * 2048 + col0 + bj * 128;
                    const u32x4 g0 = *(const u32x4*)gp, g1 = *(const u32x4*)(gp + 1024);
#define MK_RT(a, b) ((a) * __builtin_amdgcn_rcpf(fmaxf((b), 1e-30f)))
                    f32x4& v0 = acc[ai][bj][m][0]; f32x4& v1 = acc[ai][bj][m][1];
                    v0[0] *= MK_RT(bflo(g0.x), bflo(g1.x)); v0[1] *= MK_RT(bfhi(g0.x), bfhi(g1.x)); v0[2] *= MK_RT(bflo(g0.y), bflo(g1.y)); v0[3] *= MK_RT(bfhi(g0.y), bfhi(g1.y));
                    v1[0] *= MK_RT(bflo(g0.z), bflo(g1.z)); v1[1] *= MK_RT(bfhi(g0.z), bfhi(g1.z)); v1[2] *= MK_RT(bflo(g0.w), bflo(g1.w)); v1[3] *= MK_RT(bfhi(g0.w), bfhi(g1.w));
#undef MK_RT
                }
            }
    }
    __device__ __forceinline__ void operator()(const f32x4 (&acc)[2][2][4][2], const Unit& u, int wr, int wc, int fr, int fq) const {
        const int row0 = u.pm * 256 + wr * 64 + fr, col0 = u.pn * 256 + wc * 32 + 8 * fq;
#pragma unroll
        for (int ai = 0; ai < 2; ++ai)
#pragma unroll
            for (int m = 0; m < 4; ++m) {
                const int row = row0 + ai * 128 + m * 16;
#pragma unroll
                for (int bj = 0; bj < 2; ++bj) {
                    const u32x4 gw = *(const u32x4*)(G + (size_t)row * 2048 + 1024 + col0 + bj * 128);
                    f32x4 v0 = acc[ai][bj][m][0], v1 = acc[ai][bj][m][1];
                    v0[0] *= bflo(gw.x); v0[1] *= bfhi(gw.x); v0[2] *= bflo(gw.y); v0[3] *= bfhi(gw.y);
                    v1[0] *= bflo(gw.z); v1[1] *= bfhi(gw.z); v1[2] *= bflo(gw.w); v1[3] *= bfhi(gw.w);
                    u32x4 w; w.x = pk2(v0[0], v0[1]); w.y = pk2(v0[2], v0[3]); w.z = pk2(v1[0], v1[1]); w.w = pk2(v1[2], v1[3]);
                    *(u32x4*)(MRG + (size_t)row * 1024 + col0 + bj * 128) = w; }
            }
    }
};
struct EpiResid {
    static constexpr bool PERM = true, AFTER_DRAIN = false;
    float* out; bf16_t* xbf; float* RS; int wr_aux;
    __device__ __forceinline__ void operator()(const f32x4 (&acc)[2][2][4][2], const Unit& u, int wr, int wc, int fr, int fq) const {
        const int row0 = u.pm * 256 + wr * 64 + fr, col0 = u.pn * 256 + wc * 32 + 8 * fq;
#pragma unroll
        for (int ai = 0; ai < 2; ++ai)
#pragma unroll
            for (int m = 0; m < 4; ++m) {
                const int row = row0 + ai * 128 + m * 16; float ss = 0.f;
#pragma unroll
                for (int bj = 0; bj < 2; ++bj) {
                    const size_t off = (size_t)row * 1024 + col0 + bj * 128;
                    const u32x4 xw = *(const u32x4*)(xbf + off);
                    f32x4 v0 = acc[ai][bj][m][0], v1 = acc[ai][bj][m][1];
                    v0[0] += bflo(xw.x); v0[1] += bfhi(xw.x); v0[2] += bflo(xw.y); v0[3] += bfhi(xw.y);
                    v1[0] += bflo(xw.z); v1[1] += bfhi(xw.z); v1[2] += bflo(xw.w); v1[3] += bfhi(xw.w);
                    if (wr_aux) {
                        const f32x4 q0 = v0 * v0, q1 = v1 * v1; ss += ((q0[0] + q0[1]) + (q0[2] + q0[3])) + ((q1[0] + q1[1]) + (q1[2] + q1[3]));
                        u32x4 w; w.x = pk2(v0[0], v0[1]); w.y = pk2(v0[2], v0[3]); w.z = pk2(v1[0], v1[1]); w.w = pk2(v1[2], v1[3]);
                        *(u32x4*)(xbf + off) = w;
                    } else { *(f32x4*)(out + off) = v0; *(f32x4*)(out + off + 4) = v1; }
                }
                if (wr_aux) { ss += __shfl_xor(ss, 16); ss += __shfl_xor(ss, 32); if (fq == 0) RS[(size_t)row * 16 + u.pn * 4 + wc] = ss; }
            }
    }
};
struct EpiUp {
    static constexpr bool PERM = true, AFTER_DRAIN = false;
    bf16_t* H; const float* RS;
    __device__ __forceinline__ void operator()(const f32x4 (&acc)[2][2][4][2], const Unit& u, int wr, int wc, int fr, int fq) const {
        const int row0 = u.pm * 256 + wr * 64 + fr, col0 = u.pn * 256 + wc * 32 + 8 * fq;
#pragma unroll
        for (int ai = 0; ai < 2; ++ai)
#pragma unroll
            for (int m = 0; m < 4; ++m) {
                const int row = row0 + ai * 128 + m * 16; const float r = rstd_row(RS, row, fq);
#pragma unroll
                for (int bj = 0; bj < 2; ++bj) {
                    f32x4 v0 = acc[ai][bj][m][0] * r, v1 = acc[ai][bj][m][1] * r;
#pragma unroll
                    for (int i = 0; i < 4; ++i) { const float a = fmaxf(v0[i], 0.f), b = fmaxf(v1[i], 0.f); v0[i] = a * a; v1[i] = b * b; }
                    u32x4 w; w.x = pk2(v0[0], v0[1]); w.y = pk2(v0[2], v0[3]); w.z = pk2(v1[0], v1[1]); w.w = pk2(v1[2], v1[3]);
                    __builtin_nontemporal_store(w, (u32x4*)(H + (size_t)row * FF + col0 + bj * 128)); }
            }
    }
};

__device__ __forceinline__ int qk_perm_row(int n) {
    if (n < 512 || n >= 2560) return n;
    const int c = n - 512; return 512 + (c & ~255) + 128 * ((c >> 5) & 1) + 32 * ((c >> 6) & 3) + (c & 31);
}
__device__ __forceinline__ void transpose_item(const float* W, int K, int N, bf16_t* WT, int row_off, const float* gk, bool permqk, LAS float* scr, int item, int lane) {
    const int nblk = N / 64, kb = item / nblk, nb = item % nblk, k0 = 64 * kb, n0 = 64 * nb, kr = lane >> 4, nc = lane & 15;
    f32x4 v[16];
#pragma unroll
    for (int i = 0; i < 16; ++i) v[i] = *(const f32x4*)(W + (size_t)(k0 + 4 * i + kr) * N + n0 + 4 * nc);
    if (gk) {
#pragma unroll
        for (int i = 0; i < 16; ++i) v[i] = v[i] * gk[k0 + 4 * i + kr];
    }
#pragma unroll
    for (int i = 0; i < 16; ++i)
#pragma unroll
        for (int e = 0; e < 4; ++e) scr[(4 * nc + e) * 65 + 4 * i + kr] = v[i][e];
    asm volatile("s_waitcnt lgkmcnt(0)" ::: "memory");
    const int c = lane & 7;
#pragma unroll
    for (int j = 0; j < 8; ++j) { const int n = (lane >> 3) + 8 * j; const LAS float* s = scr + n * 65 + 8 * c;
        u32x4 o; o.x = pk2(s[0], s[1]); o.y = pk2(s[2], s[3]); o.z = pk2(s[4], s[5]); o.w = pk2(s[6], s[7]);
        const int dr = permqk ? qk_perm_row(n0 + n) : (n0 + n);
        *(u32x4*)(WT + (size_t)(row_off + dr) * K + k0 + 8 * c) = o; }
    asm volatile("s_waitcnt lgkmcnt(0)" ::: "memory");
}

struct Args { const float* in[17]; float* out; unsigned char* ws; };

__device__ __forceinline__ void p0_phase(const Args& a, int l, LAS unsigned char* lds, int vcu, int G) {
    const int tid = fresh_tid(), lane = tid & 63, wave = __builtin_amdgcn_readfirstlane(tid >> 6);
    LAS float* scr = (LAS float*)(lds + wave * 16640);
    const int gw = vcu * 8 + wave, NGW = G * 8;
    bf16_t* Wb = (bf16_t*)(a.ws + (l ? WS_W1 : WS_W));
    if (blockIdx.x == 0 && tid < 16) ((unsigned*)a.ws)[64 * tid] = 0u;
    const float* g_mix = a.in[1] + (size_t)l * 1024; const float* w_in = a.in[2] + (size_t)l * 1024 * IN_;
    const float* w_grp = a.in[3] + (size_t)l * 4 * 128 * 128; const float* pscale = a.in[4] + (size_t)l * 512;
    const float* w_bp = a.in[9] + (size_t)l * 512 * 1024; const float* w_ba = a.in[10] + (size_t)l * 1024 * 1024;
    const float* w_gate = a.in[11] + (size_t)l * 1024 * NGATE; const float* w_out = a.in[13] + (size_t)l * 1024 * 1024;
    const float* g_ffn = a.in[14] + (size_t)l * 1024; const float* w_up = a.in[15] + (size_t)l * 1024 * FF; const float* w_down = a.in[16] + (size_t)l * FF * 1024;
    constexpr int I_IN = 16 * (IN_ / 64), I_GATE = 16 * (NGATE / 64), I_BA = 16 * 16, I_OUT = 16 * 16, I_UP = 16 * (FF / 64), I_DOWN = 64 * 16;
    constexpr int NITEMS = I_IN + I_GATE + I_BA + I_OUT + I_UP + I_DOWN;
    for (int it = gw; it < NITEMS; it += NGW) {
        int r = it;
        if (r < I_IN) { transpose_item(w_in, 1024, IN_, Wb + WO_CAT, 0, g_mix, true, scr, r, lane); continue; } r -= I_IN;
        if (r < I_GATE) { transpose_item(w_gate, 1024, NGATE, Wb + WO_CAT, IN_, g_mix, false, scr, r, lane); continue; } r -= I_GATE;
        if (r < I_BA) { transpose_item(w_ba, 1024, 1024, Wb + WO_BA, 0, nullptr, false, scr, r, lane); continue; } r -= I_BA;
        if (r < I_OUT) { transpose_item(w_out, 1024, 1024, Wb + WO_OUT, 0, nullptr, false, scr, r, lane); continue; } r -= I_OUT;
        if (r < I_UP) { transpose_item(w_up, 1024, FF, Wb + WO_UP, 0, g_ffn, false, scr, r, lane); continue; } r -= I_UP;
        transpose_item(w_down, FF, 1024, Wb + WO_DOWN, 0, nullptr, false, scr, r, lane);
    }
    __syncthreads();
    for (int it = vcu; it < 64; it += G) {
        const int g = it >> 4, cb = (it >> 1) & 7, n = (it & 1) * 512 + tid;
        LAS float* wl = (LAS float*)lds;
#pragma unroll
        for (int j = 0; j < 4; ++j) { const int e = tid + 512 * j, cc = e >> 7, d = e & 127; wl[e] = w_grp[((size_t)g * 128 + cb * 16 + cc) * 128 + d] * pscale[g * 128 + d]; }
        __syncthreads();
        const float* bp = w_bp + (size_t)(g * 128) * 1024 + n;
        float acc[16];
#pragma unroll
        for (int cc = 0; cc < 16; ++cc) acc[cc] = 0.f;
#pragma unroll 8
        for (int d = 0; d < 128; ++d) { const float bv = bp[(size_t)d * 1024];
#pragma unroll
            for (int cc = 0; cc < 16; ++cc) acc[cc] += wl[cc * 128 + d] * bv; }
        u32x4 o0, o1;
        o0.x = pk2(acc[0], acc[1]); o0.y = pk2(acc[2], acc[3]); o0.z = pk2(acc[4], acc[5]); o0.w = pk2(acc[6], acc[7]);
        o1.x = pk2(acc[8], acc[9]); o1.y = pk2(acc[10], acc[11]); o1.z = pk2(acc[12], acc[13]); o1.w = pk2(acc[14], acc[15]);
        bf16_t* op = (bf16_t*)(a.ws + (l ? WS_COMB1 : WS_YP)) + (size_t)n * 1024 + g * 128 + cb * 16;
        *(u32x4*)op = o0; *(u32x4*)(op + 8) = o1;
        __syncthreads();
    }
    if (l == 0) {
        const float* x = a.in[0]; bf16_t* xbf = (bf16_t*)(a.ws + WS_XBF); float* RS = (float*)(a.ws + WS_RS);
        for (int m = gw; m < M_; m += NGW) {
            const f32x4* xr = (const f32x4*)(x + (size_t)m * 1024) + lane; f32x4 v[4]; float s = 0.f;
#pragma unroll
            for (int j = 0; j < 4; ++j) { v[j] = xr[64 * j]; const f32x4 q = v[j] * v[j]; s += (q[0] + q[1]) + (q[2] + q[3]); }
            s = wave_sum(s);
            unsigned long long* o8 = (unsigned long long*)(xbf + (size_t)m * 1024) + lane;
#pragma unroll
            for (int j = 0; j < 4; ++j) o8[64 * j] = (unsigned long long)pk2(v[j][0], v[j][1]) | ((unsigned long long)pk2(v[j][2], v[j][3]) << 32);
            if (lane < 16) RS[(size_t)m * 16 + lane] = lane == 0 ? s : 0.f;
        }
    }
}

template <int W> __device__ __forceinline__ void mix_item(const bf16_t* U, bf16_t* YP, int blk, int g, int lane) {
    const int sub = lane >> 4, ch = lane & 15, row0 = blk * 32 + sub * 8, t0 = row0 & (S_ - 1);
    const bf16_t* p = U + (size_t)row0 * 512 + g * 128 + ch * 8;
    u32x4 v[W + 7];
#pragma unroll
    for (int i = 0; i < W + 7; ++i) { const int dt = i - (W - 1); v[i] = (t0 + dt >= 0) ? *(const u32x4*)(p + (ptrdiff_t)dt * 512) : (u32x4){0u, 0u, 0u, 0u}; }
#pragma unroll
    for (int r = 0; r < 8; ++r) {
        float s0 = 0.f, s1 = 0.f, s2 = 0.f, s3 = 0.f, s4 = 0.f, s5 = 0.f, s6 = 0.f, s7 = 0.f;
#pragma unroll
        for (int j = 0; j < W; ++j) { const u32x4 x = v[r + W - 1 - j];
            s0 += bflo(x.x); s1 += bfhi(x.x); s2 += bflo(x.y); s3 += bfhi(x.y); s4 += bflo(x.z); s5 += bfhi(x.z); s6 += bflo(x.w); s7 += bfhi(x.w); }
        const int t = t0 + r; const float inv = 1.0f / (float)((t + 1 < W) ? (t + 1) : W); const u32x4 self = v[r + W - 1];
        u32x4 o; o.x = pk2(s0 * inv - bflo(self.x), s1 * inv - bfhi(self.x)); o.y = pk2(s2 * inv - bflo(self.y), s3 * inv - bfhi(self.y));
        o.z = pk2(s4 * inv - bflo(self.z), s5 * inv - bfhi(self.z)); o.w = pk2(s6 * inv - bflo(self.w), s7 * inv - bfhi(self.w));
        *(u32x4*)(YP + (size_t)(row0 + r) * 1024 + g * 128 + ch * 8) = o;
    }
}
__device__ __forceinline__ void mix_phase(const bf16_t* U, bf16_t* YP, int vcu, int G) {
    const int tid = fresh_tid(), lane = tid & 63, wave = __builtin_amdgcn_readfirstlane(tid >> 6);
    for (int it = vcu * 8 + wave; it < (M_ / 32) * 4; it += G * 8) {
        const int g = it & 3, blk = it >> 2;
        if (g == 0) mix_item<2>(U, YP, blk, 0, lane); else if (g == 1) mix_item<4>(U, YP, blk, 1, lane); else if (g == 2) mix_item<8>(U, YP, blk, 2, lane); else mix_item<16>(U, YP, blk, 3, lane);
    }
}

__device__ __forceinline__ int crow(int r, int hi) { return (r & 3) + 8 * (r >> 2) + 4 * hi; }
__device__ __forceinline__ s16x4 vtr(const LAS unsigned char* p) { return __builtin_bit_cast(s16x4, __builtin_amdgcn_ds_read_tr16_b64_v4i16((LAS v4i16_t*)p)); }
constexpr int AT_STG = 32768, AT_VOF = 16384, AT_WSF = 3 * AT_STG;
static_assert(AT_WSF + 2048 <= 131072 && AT_WSF >= 65536, "attention LDS map");
__device__ __forceinline__ void glds16(const void* gsrc, unsigned lds_dst) { unsigned keep;
    asm volatile("s_mov_b32 %0, m0\n\ts_mov_b32 m0, %2\n\ts_nop 0\n\tglobal_load_lds_dwordx4 %1, off\n\ts_mov_b32 m0, %0" : "=&s"(keep) : "v"(gsrc), "s"(lds_dst) : "memory"); }
#define AT_WAIT_BAR(N) asm volatile("s_waitcnt vmcnt(" #N ") lgkmcnt(0)\n\ts_barrier" ::: "memory")

__device__ __forceinline__ void attn_unit(int b, int h, int qb, const bf16_t* Q, const bf16_t* K, const bf16_t* V, bf16_t* O, const float* gsub, float lam, float oscale, float M2, int kt_lo, LAS unsigned char* lds, int tid, bool do_store = true) {
    const int lane = tid & 63, r32 = lane & 31, hi = lane >> 5, wid = __builtin_amdgcn_readfirstlane(tid >> 6), rg = wid & 3, mp = wid >> 2;
    const size_t rowbase = (size_t)b * S_; const int q0 = qb * 128;
    const bf16_t* Qw = Q + (rowbase + q0 + 32 * rg + r32) * 1024 + h * 128 + mp * 64 + hi * 8;
    bf16x8 qr[4];
#pragma unroll
    for (int d0 = 0; d0 < 4; ++d0) qr[d0] = *(const bf16x8*)(Qw + d0 * 16);
    const int NT = 2 * qb + 2, ktmax = 2 * qb + (rg >> 1);
    const float sl2 = __builtin_amdgcn_exp2f(-(float)(h + 1)) * LOG2E;
    const int drow = 8 * wid + (lane >> 4), dch = lane & 15;
    const bf16_t* ks0 = K + (rowbase + (size_t)kt_lo * 64 + drow) * 1024 + h * 128 + ((dch ^ (drow & 15)) << 3);
    const bf16_t* ks1 = K + (rowbase + (size_t)kt_lo * 64 + drow + 4) * 1024 + h * 128 + ((dch ^ ((drow + 4) & 15)) << 3);
    const bf16_t* vs0 = V + (rowbase + (size_t)kt_lo * 64 + drow) * 1024 + h * 128 + ((dch ^ ((drow & 3) << 2)) << 3);
    const bf16_t* vs1 = vs0 + 4 * 1024;
    const unsigned ldsb = (unsigned)(size_t)lds + (unsigned)wid * 2048u;
#define AT_DMA(stage) do { const unsigned d_ = (unsigned)__builtin_amdgcn_readfirstlane((int)(ldsb + (unsigned)(stage) * AT_STG)); \
        glds16(ks0, d_); glds16(ks1, d_ + 1024u); glds16(vs0, d_ + AT_VOF); glds16(vs1, d_ + AT_VOF + 1024u); \
        ks0 += 64 * 1024; ks1 += 64 * 1024; vs0 += 64 * 1024; vs1 += 64 * 1024; } while (0)
    int st_c = 0;
    AT_DMA(0);
    if (kt_lo + 1 < NT) AT_DMA(1);
    asm volatile("" :: "v"(qr[0]), "v"(qr[1]), "v"(qr[2]), "v"(qr[3]));
    f32x16 o[4];
#pragma unroll
    for (int c = 0; c < 4; ++c)
#pragma unroll
        for (int r = 0; r < 16; ++r) o[c][r] = 0.f;
    float l = 0.f;
    int kofs[4], vofs[4];
    { const int q4 = (lane & 15) >> 2, p4 = lane & 3, blk = (lane >> 4) & 1;
#pragma unroll
      for (int d0 = 0; d0 < 4; ++d0) kofs[d0] = r32 * 256 + (((mp * 8 + 2 * d0 + hi) ^ (r32 & 15)) << 4);
#pragma unroll
      for (int c = 0; c < 4; ++c) vofs[c] = AT_VOF + (4 * hi + q4) * 256 + ((((c ^ q4) << 2) | (blk << 1) | (p4 >> 1)) << 4) + 8 * (p4 & 1); }
    const float qposf = (float)(q0 + 32 * rg + r32 - 4 * hi);
    for (int kt = kt_lo; kt < NT; ++kt) {
        if (kt + 1 < NT) AT_WAIT_BAR(4); else AT_WAIT_BAR(0);
        if (kt + 2 < NT) AT_DMA(st_c == 0 ? 2 : st_c - 1);
        if (kt <= ktmax) {
            const LAS unsigned char* sb = lds + st_c * AT_STG;
            f32x16 s0, s1;
#pragma unroll
            for (int r = 0; r < 16; ++r) { s0[r] = -M2; s1[r] = -M2; }
#pragma unroll
            for (int d0 = 0; d0 < 4; ++d0) {
                const bf16x8 a0 = *(const LAS bf16x8*)(sb + kofs[d0]), a1 = *(const LAS bf16x8*)(sb + kofs[d0] + 32 * 256);
                s0 = __builtin_amdgcn_mfma_f32_32x32x16_bf16(a0, qr[d0], s0, 0, 0, 0);
                s1 = __builtin_amdgcn_mfma_f32_32x32x16_bf16(a1, qr[d0], s1, 0, 0, 0);
            }
            s16x4 va[4][2], vc[4][2];
#define AT_VRD(dst, ks) do { _Pragma("unroll") for (int c = 0; c < 4; ++c) { dst[c][0] = vtr(sb + vofs[c] + (ks) * 16 * 256); dst[c][1] = vtr(sb + vofs[c] + (ks) * 16 * 256 + 8 * 256); } } while (0)
#define AT_VMM(src, ks) do { _Pragma("unroll") for (int c = 0; c < 4; ++c) { const bf16x8 vf = (bf16x8){src[c][0][0], src[c][0][1], src[c][0][2], src[c][0][3], src[c][1][0], src[c][1][1], src[c][1][2], src[c][1][3]}; \
                o[c] = __builtin_amdgcn_mfma_f32_32x32x16_bf16(__builtin_bit_cast(bf16x8, pw[ks]), vf, o[c], 0, 0, 0); } } while (0)
            AT_VRD(va, 0);
            __builtin_amdgcn_sched_barrier(0);
            const float dq = qposf - (float)(kt * 64);
            float ls = 0.f;
#pragma unroll
            for (int r = 0; r < 16; ++r) { const float d = dq - (float)((r & 3) + 8 * (r >> 2));
                s0[r] = __builtin_amdgcn_exp2f(__builtin_fmaf(-sl2, __builtin_fabsf(d), s0[r]));
                s1[r] = __builtin_amdgcn_exp2f(__builtin_fmaf(-sl2, __builtin_fabsf(d - 32.0f), s1[r]));
                ls += s0[r] + s1[r]; }
            l += ls;
            u32x4 pw[4];
#pragma unroll
            for (int j = 0; j < 4; ++j) { pw[0][j] = pk2(s0[2 * j], s0[2 * j + 1]); pw[1][j] = pk2(s0[8 + 2 * j], s0[8 + 2 * j + 1]); pw[2][j] = pk2(s1[2 * j], s1[2 * j + 1]); pw[3][j] = pk2(s1[8 + 2 * j], s1[8 + 2 * j + 1]); }
            __builtin_amdgcn_sched_barrier(0);
            AT_VRD(vc, 1); __builtin_amdgcn_sched_barrier(0);
            AT_VMM(va, 0); __builtin_amdgcn_sched_barrier(0);
            AT_VRD(va, 2); __builtin_amdgcn_sched_barrier(0);
            AT_VMM(vc, 1); __builtin_amdgcn_sched_barrier(0);
            AT_VRD(vc, 3); __builtin_amdgcn_sched_barrier(0);
            AT_VMM(va, 2); __builtin_amdgcn_sched_barrier(0);
            AT_VMM(vc, 3); __builtin_amdgcn_sched_barrier(0);
#undef AT_VRD
#undef AT_VMM
        }
        st_c = (st_c == 2) ? 0 : st_c + 1;
    }
    AT_WAIT_BAR(0);
#undef AT_DMA
    l += __shfl_xor(l, 32);
    LAS float* wsf = (LAS float*)(lds + AT_WSF) + wid * 64;
    if (hi == 0) wsf[r32] = l;
    asm volatile("s_waitcnt lgkmcnt(0)" ::: "memory");
#pragma unroll
    for (int r = 0; r < 16; ++r) { const float rl = 1.0f / wsf[crow(r, hi)];
#pragma unroll
        for (int c = 0; c < 4; ++c) o[c][r] *= rl; }
    LAS float* X = (LAS float*)lds + rg * 4096;
    if (mp == 1) {
#pragma unroll
        for (int c = 0; c < 4; ++c)
#pragma unroll
            for (int r = 0; r < 16; ++r) X[crow(r, hi) * 128 + 32 * c + r32] = o[c][r];
    }
    __syncthreads();
    if (mp == 0 && do_store) {
        float gs[4];
#pragma unroll
        for (int c = 0; c < 4; ++c) gs[c] = gsub[32 * c + r32] * oscale;
#pragma unroll
        for (int r = 0; r < 16; ++r) {
            float ss = 0.f;
#pragma unroll
            for (int c = 0; c < 4; ++c) { o[c][r] -= lam * X[crow(r, hi) * 128 + 32 * c + r32]; ss += o[c][r] * o[c][r]; }
            ss += __shfl_xor(ss, 1); ss += __shfl_xor(ss, 2); ss += __shfl_xor(ss, 4); ss += __shfl_xor(ss, 8); ss += __shfl_xor(ss, 16);
            const float rn = rsqrtf(ss * (1.0f / 128.0f) + EPS);
            bf16_t* op = O + (rowbase + q0 + 32 * rg + crow(r, hi)) * 1024 + h * 128 + r32;
#pragma unroll
            for (int c = 0; c < 4; ++c) op[32 * c] = (bf16_t)(pk2(o[c][r] * rn * gs[c], 0.f) & 0xffffu);
        }
    }
    __syncthreads();
}

constexpr int AT_ORD = 131072;
constexpr float AT_THR2 = 40.0f;
__device__ __forceinline__ void attn_phase(const Args& a, int l, LAS unsigned char* lds, int bx, int pass = 0, bool do_store = true) {
    const int tid = fresh_tid(), lane = tid & 63;
    const float* gq = a.in[5] + l * 64; const float* gk = a.in[6] + l * 64; const float* lq = a.in[7] + l * 256; const float* gsub = a.in[8] + l * 128;
    const float lambda_init = 0.8f - 0.6f * expf(-0.3f * (float)l);
    const float lam = expf(wave_sum(lq[lane] * lq[64 + lane])) - expf(wave_sum(lq[128 + lane] * lq[192 + lane])) + lambda_init;
    const float M2 = 8.0f * wave_max(fabsf(gq[lane])) * wave_max(fabsf(gk[lane])) * LOG2E;
    const bf16_t* Q = (const bf16_t*)(a.ws + WS_Q); const bf16_t* K = (const bf16_t*)(a.ws + WS_K); const bf16_t* V = (const bf16_t*)(a.ws + WS_V);
    LAS int* ord = (LAS int*)(lds + AT_ORD); LAS int* cst = ord + 256; LAS int* cur = cst + 256;
    unsigned* ctr = (unsigned*)a.ws + 512 * pass;
    int my_lo = 0;
    if (tid < 256) {
        const int h = tid >> 5, qb = tid & 31;
        const float sl2 = __builtin_amdgcn_exp2f(-(float)(h + 1)) * LOG2E, Wd = (2.0f * M2 + AT_THR2) / sl2;
        const float x = ((float)(128 * qb - 63) - Wd) * (1.0f / 64.0f);
        my_lo = x > 0.f ? (int)ceilf(x) : 0;
        cst[tid] = ((2 * qb + 2 - my_lo) << 8) | my_lo;
    }
    if (tid < 256) ord[(7 - (tid >> 5)) * 32 + 31 - (tid & 31)] = tid;
    __syncthreads();
    const int xcc = (int)(__builtin_amdgcn_s_getreg((3 << 11) | 20) & 0xFu) & 7;
    for (int qi = 0; qi < 8; ++qi) {
        const int qx = (xcc + qi) & 7;
        for (;;) {
            if (tid == 0) cur[0] = (int)__hip_atomic_fetch_add(ctr + 64 * qx, 1u, __ATOMIC_RELAXED, __HIP_MEMORY_SCOPE_AGENT);
            __syncthreads();
            const int idx = cur[0];
            __syncthreads();
            if (idx >= 256) break;
            const int t = ord[idx], klo = cst[t] & 255;
            attn_unit(qx, t >> 5, t & 31, Q, K, V, (bf16_t*)(a.ws + WS_Q), gsub, lam, 1.0f - lambda_init, M2, klo, lds, tid, do_store);
        }
    }
}

#define XB_TMO      128
#define XB_XCNT(j)  (256  + 64 * (j))
#define XB_XSUB(j)  (1280 + 64 * (j))
#define XB_XGEN(j)  (2304 + 64 * (j))
#define XB_TOP      3328
#define XB_TOPGEN   3392
#define XCD_BAR_WORDS 3456
#define XB_SPIN_CAP (1u << 18)

__device__ __forceinline__ unsigned xb_ld(unsigned* p)              { return __hip_atomic_load(p, __ATOMIC_RELAXED, __HIP_MEMORY_SCOPE_AGENT); }
__device__ __forceinline__ unsigned xb_add(unsigned* p, unsigned v) { return __hip_atomic_fetch_add(p, v, __ATOMIC_RELAXED, __HIP_MEMORY_SCOPE_AGENT); }
__device__ __forceinline__ unsigned xb_xcc_id() { return (unsigned)__builtin_amdgcn_s_getreg((3 << 11) | 20) & 0xFu; }
#define XB_SPIN(cond, bar) do { unsigned _sp = 0; while (cond) { __builtin_amdgcn_s_sleep(1); \
    if ((++_sp & 255u) == 0u) { if (xb_ld(&(bar)[XB_TMO])) break; if (_sp > XB_SPIN_CAP) { atomicAdd(&(bar)[XB_TMO], 1u); break; } } } } while (0)

struct XcdBarrier {
    unsigned* bar; unsigned x;
    volatile __attribute__((address_space(3))) unsigned* st;
};

__device__ __forceinline__ XcdBarrier xcd_barrier_post(unsigned* bar, volatile __attribute__((address_space(3))) unsigned* st) {
    XcdBarrier b; b.bar = bar; b.x = xb_xcc_id(); b.st = st;
    if (threadIdx.x == 0) (void)xb_add(&bar[XB_XCNT(b.x)], 1u);
    return b;
}
__device__ __forceinline__ void xcd_barrier_complete(unsigned* bar, unsigned x, unsigned& nloc, unsigned& nx) {
    const unsigned G = gridDim.x * gridDim.y * gridDim.z;
    unsigned sum, cnt, mine, sp = 0u;
    for (;;) {
        sum = 0u; cnt = 0u; mine = 0u;
#pragma unroll
        for (unsigned j = 0; j < 16; ++j) { const unsigned c = xb_ld(&bar[XB_XCNT(j)]); sum += c; cnt += (c > 0u) ? 1u : 0u; mine = (j == x) ? c : mine; }
        if (sum == G) break;
        __builtin_amdgcn_s_sleep(1);
        if ((++sp & 255u) == 0u) { if (xb_ld(&bar[XB_TMO])) break; if (sp > XB_SPIN_CAP) { atomicAdd(&bar[XB_TMO], 1u); break; } }
    }
    nloc = mine > 0u ? mine : 1u; nx = cnt > 0u ? cnt : 1u;
}

__device__ __forceinline__ void xcd_barrier(const XcdBarrier& b) {
    asm volatile("s_waitcnt vmcnt(0)" ::: "memory");
    __syncthreads();
    if (threadIdx.x == 0) {
        unsigned* bar = b.bar;
        __builtin_amdgcn_s_waitcnt(0);
        unsigned nloc = b.st[0], nx = b.st[1];
        if (nloc == 0u) { xcd_barrier_complete(bar, b.x, nloc, nx); b.st[0] = nloc; b.st[1] = nx; }
        const unsigned old = xb_add(&bar[XB_XSUB(b.x)], 1u);
        const unsigned gen = old / nloc;
        if (old + 1u == (gen + 1u) * nloc) {
            __builtin_amdgcn_fence(__ATOMIC_RELEASE, "agent");
            asm volatile("s_waitcnt vmcnt(0)" ::: "memory");
            const unsigned og = xb_add(&bar[XB_TOP], 1u);
            const unsigned tg = og / nx;
            if (og + 1u == (tg + 1u) * nx) xb_add(&bar[XB_TOPGEN], 1u);
            else XB_SPIN(xb_ld(&bar[XB_TOPGEN]) == tg, bar);
            __builtin_amdgcn_fence(__ATOMIC_ACQUIRE, "agent");
            xb_add(&bar[XB_XGEN(b.x)], 1u);
            asm volatile("s_waitcnt vmcnt(0)" ::: "memory");
        } else {
            XB_SPIN(xb_ld(&bar[XB_XGEN(b.x)]) == gen, bar);
            __builtin_amdgcn_fence(__ATOMIC_ACQUIRE, "agent");
            asm volatile("s_waitcnt vmcnt(0)" ::: "memory");
        }
    }
    __syncthreads();
}

__global__ void __launch_bounds__(512, 2) fwd(Args a) {
    extern __shared__ __attribute__((aligned(16))) unsigned char lds_raw[];
    LAS unsigned char* lds = (LAS unsigned char*)lds_raw;
    cg::grid_group grid = cg::this_grid();
    const int G = gridDim.x, bx = blockIdx.x, vcu = (G % 8 == 0) ? (bx % 8) * (G / 8) + bx / 8 : bx;
    unsigned char* ws = a.ws;
    bf16_t* Wb; bf16_t* XBF = (bf16_t*)(ws + WS_XBF); float* RS = (float*)(ws + WS_RS);
    bf16_t* Ub = (bf16_t*)(ws + WS_U); bf16_t* Qb = (bf16_t*)(ws + WS_Q); bf16_t* Kb = (bf16_t*)(ws + WS_K); bf16_t* Vb = (bf16_t*)(ws + WS_V);
    bf16_t* Gb = (bf16_t*)(ws + WS_G); bf16_t* YP = (bf16_t*)a.out;
    bf16_t* WCOMB;     bf16_t* MRG = (bf16_t*)(ws + WS_MRG); bf16_t* Hb = (bf16_t*)(ws + WS_H);
    unsigned* barw = (unsigned*)ws + 4096;
    if (bx == 0) for (int i = threadIdx.x; i < XCD_BAR_WORDS; i += 512) barw[i] = 0u;
    volatile LAS unsigned* bst = (volatile LAS unsigned*)(lds + 135168);
    if (threadIdx.x < 2) bst[threadIdx.x] = 0u;
    __syncthreads();
    XcdBarrier xbar; xbar.bar = barw; xbar.x = 0; xbar.st = bst;
#define SEAM() xcd_barrier(xbar)
#if PHM & 1
    p0_phase(a, 0, lds, vcu, G);
    p0_phase(a, 1, lds, vcu, G);
#endif
    grid.sync(); xbar = xcd_barrier_post(barw, bst);
    for (int l = 0; l < DEPTH; ++l) {
        Wb = (bf16_t*)(ws + (l ? WS_W1 : WS_W)); WCOMB = (bf16_t*)(ws + (l ? WS_COMB1 : WS_YP));
#if PHM & 2
        {
            pg8::Gemm g{XBF, Wb + WO_CAT, M_, NCAT, 1024}; pg8::StaticOrder S; S.init(M_, NCAT, G, bx);
            EpiIn E{Ub, Qb, Kb, Vb, Gb, RS, a.in[5] + l * 64, a.in[6] + l * 64, a.in[12] + (size_t)l * NGATE};
            pg8::gemm_phase<EpiIn, pg8::StaticOrder, true, true>(lds, g, S, E);
#if PROBE_DUP == 2
            grid.sync(); pg8::gemm_phase<EpiIn, pg8::StaticOrder, true, true>(lds, g, S, E);
#endif
        }
#endif
        SEAM();
#if PHM & 4
        mix_phase(Ub, YP, vcu, G);
#if PROBE_DUP == 3
        grid.sync(); mix_phase(Ub, YP, vcu, G);
#endif
#endif
#if PHM & 8
#if PROBE_DUP == 4
        attn_phase(a, l, lds, bx, 1, a.ws == nullptr); grid.sync();
#endif
        attn_phase(a, l, lds, bx, l);
#endif
        SEAM();
#if PHM & 16
        {
            pg8::StaticOrder S; S.init(M_, 1024, G, bx);
            { pg8::Gemm g{YP, WCOMB, M_, 1024, 1024, 512}; EpiMerge2 E{Gb, MRG}; pg8::gemm_phase2<EpiMerge2, pg8::StaticOrder, true, true>(lds, g, Qb, Wb + WO_BA, 1024, S, E); }
        }
#endif
        SEAM();
#if PHM & 32
        {
            pg8::Gemm g{MRG, Wb + WO_OUT, M_, 1024, 1024}; pg8::StaticOrder S; S.init(M_, 1024, G, bx);
            EpiResid E{a.out, XBF, RS, 1};
            pg8::gemm_phase<EpiResid, pg8::StaticOrder, true, true>(lds, g, S, E);
        }
        SEAM();
#endif
#if PHM & 64
        {
            pg8::Gemm g{XBF, Wb + WO_UP, M_, FF, 1024}; pg8::StaticOrder S; S.init(M_, FF, G, bx);
            EpiUp E{Hb, RS};
            pg8::gemm_phase<EpiUp, pg8::StaticOrder, true, true>(lds, g, S, E);
#if PROBE_DUP == 6
            grid.sync(); pg8::gemm_phase<EpiUp, pg8::StaticOrder, true, true>(lds, g, S, E);
#endif
        }
        SEAM();
#endif
#if PHM & 128
        {
            pg8::Gemm g{Hb, Wb + WO_DOWN, M_, 1024, FF}; pg8::StaticOrder S; S.init(M_, 1024, G, bx);
            EpiResid E{a.out, XBF, RS, l + 1 < DEPTH ? 1 : 0};
            pg8::gemm_phase<EpiResid, pg8::StaticOrder, true, true>(lds, g, S, E);
        }
#endif
        if (l + 1 < DEPTH) SEAM();
#if PROBE_DUP == 7
        for (int i = 0; i < 10; ++i) SEAM();
#endif
    }
}
}

extern "C" void kernel_launch(void* const* d_in, const int* in_sizes, int n_in, void* d_out, int out_size, void* d_ws, size_t ws_size, hipStream_t stream) {
    static int grid = 0;
    if (grid == 0) {
        if (n_in != 17 || out_size != mk::M_ * mk::D_ || ws_size < mk::WS_END) { fprintf(stderr, "kernel_launch: unexpected shapes (n_in %d, out %d, ws %zu)\n", n_in, out_size, ws_size); grid = -1; return; }
        int dev = 0, cus = 0, per_cu = 0;
        hipGetDevice(&dev);
        hipDeviceGetAttribute(&cus, hipDeviceAttributeMultiprocessorCount, dev);
        if (hipFuncSetAttribute((const void*)mk::fwd, hipFuncAttributeMaxDynamicSharedMemorySize, mk::LDS_BYTES) != hipSuccess) { fprintf(stderr, "kernel_launch: hipFuncSetAttribute failed\n"); grid = -1; return; }
        hipOccupancyMaxActiveBlocksPerMultiprocessor(&per_cu, (const void*)mk::fwd, 512, mk::LDS_BYTES);
        if (per_cu < 1) { fprintf(stderr, "kernel_launch: occupancy query says 0 blocks per CU\n"); per_cu = 1; }
        (void)hipGetLastError();
        grid = cus;
    }
    if (grid < 0) return;
    mk::Args a{};
    for (int i = 0; i < 17; ++i) a.in[i] = (const float*)d_in[i];
    a.out = (float*)d_out; a.ws = (unsigned char*)d_ws;
    void* args[] = {&a};
    hipError_t e = hipLaunchCooperativeKernel((void*)mk::fwd, dim3(grid), dim3(512), args, mk::LDS_BYTES, stream);
    if (e != hipSuccess) fprintf(stderr, "kernel_launch: cooperative launch failed: %s (grid %d)\n", hipGetErrorString(e), grid);
}
```

```cpp
#include <hip/hip_runtime.h>
#include <hip/hip_cooperative_groups.h>
#include <cstdio>
#include <cstdint>
namespace cg = cooperative_groups;
namespace pg8 {
#define PG8_LAS __attribute__((address_space(3)))
typedef unsigned short bf16_t;
typedef short bf16x8 __attribute__((ext_vector_type(8)));
typedef float f32x4 __attribute__((ext_vector_type(4)));
typedef unsigned u32x4 __attribute__((ext_vector_type(4)));
constexpr int BM = 256, BK = 64, HALF = 128, HTB = HALF * BK * 2  , STAGE_BYTES = 8 * HTB, NXCD = 8, WGM = 8;

__host__ __device__ __forceinline__ int lds_byte(int r, int c) { const int st = (r >> 4) * 2 + (c >> 5), rr = r & 15, cc = c & 31, ob = rr * 64 + cc * 2; return st * 1024 + (ob ^ (((ob >> 9) & 1) << 5)); }
__host__ __device__ __forceinline__ void stage_rc(int b, int& R, int& C) { const int st = b / 1024, sb = b % 1024, swz = sb ^ (((sb >> 9) & 1) << 5); R = (st >> 1) * 16 + swz / 64; C = (st & 1) * 32 + (swz % 64) / 2; }
__host__ __device__ __forceinline__ int perm32(int rho) { const int n = rho >> 4, i = rho & 15; return 8 * (i >> 2) + 4 * n + (i & 3); }

struct Unit { int pm, pn; };
struct Gemm { const bf16_t* A; const bf16_t* Bt; int M, N, K; int N_seg0K = 0; int lda = 0; };

struct StaticOrder {
    int nM, nN, nwg, G, c, wgm;
    __host__ __device__ void init(int M, int N, int G_, int c_, int wgm_ = WGM) { nM = M / BM; nN = N / BM; nwg = nM * nN; G = G_; c = c_; wgm = wgm_; }
    __host__ __device__ bool next(int i, Unit& u) const {
        const long L = (long)i * G + c; if (L >= nwg) return false;
        int wgid = (int)L; { const int q = nwg / NXCD, r = nwg % NXCD, xcd = wgid % NXCD, off = wgid / NXCD; wgid = (xcd < r ? xcd * (q + 1) : r * (q + 1) + (xcd - r) * q) + off; }
        const int nig = wgm * nN, gid = wgid / nig, fm = gid * wgm, gsz = (nM - fm) < wgm ? (nM - fm) : wgm;
        u.pm = fm + ((wgid % nig) % gsz); u.pn = (wgid % nig) / gsz; return true;
    }
    __device__ __forceinline__ void a_ready(const Unit&) const {}
    __device__ __forceinline__ void done(const Unit&) const {}
};
__device__ __forceinline__ unsigned cvt_pk_bf16(float lo, float hi) { unsigned r; asm volatile("v_cvt_pk_bf16_f32 %0, %1, %2" : "=v"(r) : "v"(lo), "v"(hi)); return r; }
typedef float f32x2 __attribute__((ext_vector_type(2)));
template <class Epi, class Sched, bool ALIGN_EPI = false, bool SP2 = false>
__device__ __forceinline__ void gemm_phase(PG8_LAS unsigned char* lds, const Gemm g, const Sched& S, const Epi& E) {
    int tid_ = threadIdx.x; asm volatile("" : "+v"(tid_));
    const int tid = tid_, wid = __builtin_amdgcn_readfirstlane(tid >> 6), lane = tid & 63, wr = wid >> 2, wc = wid & 3, fr = lane & 15, fq = lane >> 4;
    const int K = g.K, nt = K / BK, lda = g.lda ? g.lda : K;
    unsigned voffA[2], voffB[2];
#pragma unroll
    for (int i = 0; i < 2; ++i) { int R, C; stage_rc(tid * 16 + i * 8192, R, C); const int Rb = Epi::PERM ? ((R & ~31) + perm32(R & 31)) : R;
        voffA[i] = (unsigned)(R * lda + C) * 2u; voffB[i] = (unsigned)(Rb * K + C) * 2u; }
    const size_t kstep = (size_t)(BK * 2);
    const size_t hstepA = (size_t)HALF * lda * 2, hstepB = (size_t)HALF * K * 2;
    const size_t tstepA = 2 * hstepA, tstepB = 2 * hstepB;
    const unsigned ldsw = (unsigned)wid * 1024u;
    const int aoff = lds_byte(wr * 64 + fr, fq * 8), boff = lds_byte(wc * 32 + fr, fq * 8);
#define PG8_SA(b, h) (((b) * 2 + (h)) * HTB)
#define PG8_SB(b, h) ((4 + (b) * 2 + (h)) * HTB)
#define PG8_STAGE(bufoff, gbase, voff) do { _Pragma("unroll") for (int _i = 0; _i < 2; ++_i) \
        __builtin_amdgcn_global_load_lds((const unsigned*)((const char*)(gbase) + (voff)[_i]), (PG8_LAS unsigned*)(lds + (bufoff) + ldsw + _i * 8192), 16, 0, 0); } while (0)
#define PG8_LDA(dst, b, h) do { _Pragma("unroll") for (int m = 0; m < 4; ++m) _Pragma("unroll") for (int k = 0; k < 2; ++k) dst[m][k] = *(const PG8_LAS bf16x8*)(lds + PG8_SA(b, h) + aoff + m * 2048 + k * 1024); } while (0)
#define PG8_LDB(dst, b, h) do { _Pragma("unroll") for (int n = 0; n < 2; ++n) _Pragma("unroll") for (int k = 0; k < 2; ++k) dst[n][k] = *(const PG8_LAS bf16x8*)(lds + PG8_SB(b, h) + boff + n * 2048 + k * 1024); } while (0)
#define PG8_MMA(ai, bj, At, Bt) do { __builtin_amdgcn_s_setprio(1); _Pragma("unroll") for (int m = 0; m < 4; ++m) _Pragma("unroll") for (int n = 0; n < 2; ++n) _Pragma("unroll") for (int k = 0; k < 2; ++k) \
        acc[ai][bj][m][n] = __builtin_amdgcn_mfma_f32_16x16x32_bf16(Bt[n][k], At[m][k], acc[ai][bj][m][n], 0, 0, 0); __builtin_amdgcn_s_setprio(0); } while (0)
#define PG8_WAIT_V(n) asm volatile("s_waitcnt vmcnt(" #n ")" ::: "memory")
#define PG8_WAIT_L(n) asm volatile("s_waitcnt lgkmcnt(" #n ")" ::: "memory")
#define PG8_BAR __builtin_amdgcn_s_barrier()
#define PG8_SCHED __builtin_amdgcn_sched_barrier(0)
    Unit cur, nxt; int ui = 0;
    if (!S.next(0, cur)) return;
    f32x4 acc[2][2][4][2];
#pragma unroll
    for (int a = 0; a < 2; ++a)
#pragma unroll
        for (int b = 0; b < 2; ++b)
#pragma unroll
            for (int m = 0; m < 4; ++m)
#pragma unroll
                for (int n = 0; n < 2; ++n) acc[a][b][m][n] = (f32x4){0.f, 0.f, 0.f, 0.f};
    bf16x8 At[4][2], B0[2][2], B1[2][2];
    const char* cA = (const char*)g.A + (size_t)cur.pm * tstepA; const char* cB = (const char*)g.Bt + (size_t)cur.pn * tstepB;
    S.a_ready(cur);
    if constexpr (SP2) {
        PG8_STAGE(PG8_SB(0, 0), cB, voffB); PG8_STAGE(PG8_SB(0, 1), cB + hstepB, voffB); PG8_STAGE(PG8_SA(0, 0), cA, voffA); PG8_STAGE(PG8_SA(0, 1), cA + hstepA, voffA);
        if (wr == 1) PG8_BAR;
        PG8_WAIT_V(2); PG8_BAR;
        PG8_STAGE(PG8_SB(1, 0), cB + kstep, voffB); PG8_STAGE(PG8_SA(1, 0), cA + kstep, voffA); PG8_STAGE(PG8_SB(1, 1), cB + hstepB + kstep, voffB);
        PG8_WAIT_V(6); PG8_BAR;
    } else {
        PG8_STAGE(PG8_SB(0, 0), cB, voffB); PG8_STAGE(PG8_SA(0, 0), cA, voffA); PG8_STAGE(PG8_SB(0, 1), cB + hstepB, voffB); PG8_STAGE(PG8_SA(0, 1), cA + hstepA, voffA);
        if (wr == 1) PG8_BAR;
        PG8_WAIT_V(4); PG8_BAR;
        PG8_STAGE(PG8_SB(1, 0), cB + kstep, voffB); PG8_STAGE(PG8_SA(1, 0), cA + kstep, voffA); PG8_STAGE(PG8_SB(1, 1), cB + hstepB + kstep, voffB);
        PG8_WAIT_V(6); PG8_BAR;
    }
    for (;;) {
        const bool has_next = S.next(ui + 1, nxt);
        const char* nA = has_next ? (const char*)g.A + (size_t)nxt.pm * tstepA : cA; const char* nB = has_next ? (const char*)g.Bt + (size_t)nxt.pn * tstepB : cB;
        for (int t = 0; t < nt; t += 2) {
            const bool last = (t == nt - 2);
            const char* a1 = cA + (size_t)(t + 1) * kstep;
            const char* a2 = last ? nA : cA + (size_t)(t + 2) * kstep; const char* b2 = last ? nB : cB + (size_t)(t + 2) * kstep;
            const char* a3 = a2 + kstep; const char* b3 = b2 + kstep;
            if (last && has_next) S.a_ready(nxt);
            if constexpr (SP2) {
            PG8_LDB(B0, 0, 0); PG8_LDB(B1, 0, 1); PG8_SCHED; PG8_LDA(At, 0, 0); PG8_STAGE(PG8_SA(1, 1), a1 + hstepA, voffA);
            PG8_WAIT_V(8); PG8_WAIT_L(0); PG8_BAR; PG8_MMA(0, 0, At, B0); PG8_MMA(0, 1, At, B1); PG8_BAR; PG8_SCHED;
            PG8_LDA(At, 0, 1); PG8_STAGE(PG8_SB(0, 0), b2, voffB); PG8_STAGE(PG8_SB(0, 1), b2 + hstepB, voffB); PG8_STAGE(PG8_SA(0, 0), a2, voffA);
            PG8_WAIT_V(8); PG8_WAIT_L(0); PG8_BAR; PG8_MMA(1, 0, At, B0); PG8_MMA(1, 1, At, B1); PG8_BAR; PG8_SCHED;
            PG8_LDB(B0, 1, 0); PG8_LDB(B1, 1, 1); PG8_SCHED; PG8_LDA(At, 1, 0); PG8_STAGE(PG8_SA(0, 1), a2 + hstepA, voffA);
            PG8_WAIT_V(8); PG8_WAIT_L(0); PG8_BAR; PG8_MMA(0, 0, At, B0); PG8_MMA(0, 1, At, B1); PG8_BAR; PG8_SCHED;
            PG8_LDA(At, 1, 1); PG8_STAGE(PG8_SB(1, 0), b3, voffB); PG8_STAGE(PG8_SB(1, 1), b3 + hstepB, voffB); PG8_STAGE(PG8_SA(1, 0), a3, voffA);
            PG8_WAIT_V(8); PG8_WAIT_L(0); PG8_BAR; PG8_MMA(1, 0, At, B0); PG8_MMA(1, 1, At, B1); PG8_BAR; PG8_SCHED;
            } else {
            PG8_LDB(B0, 0, 0); PG8_SCHED; PG8_LDA(At, 0, 0); PG8_STAGE(PG8_SA(1, 1), a1 + hstepA, voffA);
            PG8_WAIT_L(8); PG8_BAR; PG8_WAIT_L(0); PG8_MMA(0, 0, At, B0); PG8_BAR; PG8_SCHED;
            PG8_LDB(B1, 0, 1); PG8_STAGE(PG8_SB(0, 0), b2, voffB);
            PG8_BAR; PG8_WAIT_L(0); PG8_MMA(0, 1, At, B1); PG8_BAR;
            PG8_LDA(At, 0, 1); PG8_STAGE(PG8_SA(0, 0), a2, voffA);
            PG8_BAR; PG8_WAIT_L(0); PG8_MMA(1, 0, At, B0); PG8_BAR; PG8_SCHED;
            PG8_STAGE(PG8_SB(0, 1), b2 + hstepB, voffB);
            PG8_WAIT_V(6); PG8_BAR; PG8_MMA(1, 1, At, B1); PG8_BAR;
            PG8_LDB(B0, 1, 0); PG8_SCHED; PG8_LDA(At, 1, 0); PG8_STAGE(PG8_SA(0, 1), a2 + hstepA, voffA);
            PG8_WAIT_L(8); PG8_BAR; PG8_WAIT_L(0); PG8_MMA(0, 0, At, B0); PG8_BAR; PG8_SCHED;
            PG8_LDB(B1, 1, 1); PG8_STAGE(PG8_SB(1, 0), b3, voffB);
            PG8_BAR; PG8_WAIT_L(0); PG8_MMA(0, 1, At, B1); PG8_BAR;
            PG8_LDA(At, 1, 1); PG8_STAGE(PG8_SA(1, 0), a3, voffA);
            PG8_BAR; PG8_WAIT_L(0); PG8_MMA(1, 0, At, B0); PG8_BAR; PG8_SCHED;
            PG8_STAGE(PG8_SB(1, 1), b3 + hstepB, voffB);
            PG8_WAIT_V(6); PG8_BAR; PG8_MMA(1, 1, At, B1); PG8_BAR;
            }
        }
        if constexpr (ALIGN_EPI) { if (wr == 0) PG8_BAR; }
        if constexpr (!Epi::AFTER_DRAIN) { E(acc, cur, wr, wc, fr, fq); S.done(cur); }
        if (!has_next) break;
#pragma unroll
        for (int a = 0; a < 2; ++a)
#pragma unroll
            for (int b = 0; b < 2; ++b)
#pragma unroll
                for (int m = 0; m < 4; ++m)
#pragma unroll
                    for (int n = 0; n < 2; ++n) acc[a][b][m][n] = (f32x4){0.f, 0.f, 0.f, 0.f};
        cur = nxt; cA = nA; cB = nB; ++ui;
        if constexpr (ALIGN_EPI) { if (wr == 1) PG8_BAR; }
    }
    PG8_WAIT_V(0);
    if constexpr (!ALIGN_EPI) { if (wr == 0) PG8_BAR; }
    PG8_BAR;
    if constexpr (Epi::AFTER_DRAIN) { E.fused(acc, cur, wr, wc, fr, fq, lds, wid, lane); S.done(cur); }
}
template <class Epi, class Sched, bool ALIGN_EPI = false, bool SP2 = false>
__device__ __forceinline__ void gemm_phase2(PG8_LAS unsigned char* lds, const Gemm g, const bf16_t* A1, const bf16_t* Bt1, int K1, const Sched& S, const Epi& E) {
    int tid_ = threadIdx.x; asm volatile("" : "+v"(tid_));
    const int tid = tid_, wid = __builtin_amdgcn_readfirstlane(tid >> 6), lane = tid & 63, wr = wid >> 2, wc = wid & 3, fr = lane & 15, fq = lane >> 4;
    const int K = g.K  , lda = g.lda ? g.lda : K  , nt0 = g.N_seg0K / BK, nt1 = K1 / BK;
    unsigned voffA[2], voffB[2];
#pragma unroll
    for (int i = 0; i < 2; ++i) { int R, C; stage_rc(tid * 16 + i * 8192, R, C); const int Rb = Epi::PERM ? ((R & ~31) + perm32(R & 31)) : R;
        voffA[i] = (unsigned)(R * lda + C) * 2u; voffB[i] = (unsigned)(Rb * K + C) * 2u; }
    const size_t kstep = (size_t)(BK * 2);
    const size_t hstepA = (size_t)HALF * lda * 2, hstepB = (size_t)HALF * K * 2;
    const size_t tstepA = 2 * hstepA, tstepB = 2 * hstepB;
    const unsigned ldsw = (unsigned)wid * 1024u;
    const int aoff = lds_byte(wr * 64 + fr, fq * 8), boff = lds_byte(wc * 32 + fr, fq * 8);
#define PG8_SA(b, h) (((b) * 2 + (h)) * HTB)
#define PG8_SB(b, h) ((4 + (b) * 2 + (h)) * HTB)
#define PG8_STAGE(bufoff, gbase, voff) do { _Pragma("unroll") for (int _i = 0; _i < 2; ++_i) \
        __builtin_amdgcn_global_load_lds((const unsigned*)((const char*)(gbase) + (voff)[_i]), (PG8_LAS unsigned*)(lds + (bufoff) + ldsw + _i * 8192), 16, 0, 0); } while (0)
#define PG8_LDA(dst, b, h) do { _Pragma("unroll") for (int m = 0; m < 4; ++m) _Pragma("unroll") for (int k = 0; k < 2; ++k) dst[m][k] = *(const PG8_LAS bf16x8*)(lds + PG8_SA(b, h) + aoff + m * 2048 + k * 1024); } while (0)
#define PG8_LDB(dst, b, h) do { _Pragma("unroll") for (int n = 0; n < 2; ++n) _Pragma("unroll") for (int k = 0; k < 2; ++k) dst[n][k] = *(const PG8_LAS bf16x8*)(lds + PG8_SB(b, h) + boff + n * 2048 + k * 1024); } while (0)
#define PG8_MMA(ai, bj, At, Bt) do { __builtin_amdgcn_s_setprio(1); _Pragma("unroll") for (int m = 0; m < 4; ++m) _Pragma("unroll") for (int n = 0; n < 2; ++n) _Pragma("unroll") for (int k = 0; k < 2; ++k) \
        acc[ai][bj][m][n] = __builtin_amdgcn_mfma_f32_16x16x32_bf16(Bt[n][k], At[m][k], acc[ai][bj][m][n], 0, 0, 0); __builtin_amdgcn_s_setprio(0); } while (0)
#define PG8_WAIT_V(n) asm volatile("s_waitcnt vmcnt(" #n ")" ::: "memory")
#define PG8_WAIT_L(n) asm volatile("s_waitcnt lgkmcnt(" #n ")" ::: "memory")
#define PG8_BAR __builtin_amdgcn_s_barrier()
#define PG8_SCHED __builtin_amdgcn_sched_barrier(0)
    Unit cur, nxt; int ui = 0; int cseg = 0;
    if (!S.next(0, cur)) return;
    f32x4 acc[2][2][4][2];
#pragma unroll
    for (int a = 0; a < 2; ++a)
#pragma unroll
        for (int b = 0; b < 2; ++b)
#pragma unroll
            for (int m = 0; m < 4; ++m)
#pragma unroll
                for (int n = 0; n < 2; ++n) acc[a][b][m][n] = (f32x4){0.f, 0.f, 0.f, 0.f};
    bf16x8 At[4][2], B0[2][2], B1[2][2];
    const char* cA = (const char*)g.A + (size_t)cur.pm * tstepA; const char* cB = (const char*)g.Bt + (size_t)cur.pn * tstepB;
    if constexpr (SP2) {
        PG8_STAGE(PG8_SB(0, 0), cB, voffB); PG8_STAGE(PG8_SB(0, 1), cB + hstepB, voffB); PG8_STAGE(PG8_SA(0, 0), cA, voffA); PG8_STAGE(PG8_SA(0, 1), cA + hstepA, voffA);
        if (wr == 1) PG8_BAR;
        PG8_WAIT_V(2); PG8_BAR;
        PG8_STAGE(PG8_SB(1, 0), cB + kstep, voffB); PG8_STAGE(PG8_SA(1, 0), cA + kstep, voffA); PG8_STAGE(PG8_SB(1, 1), cB + hstepB + kstep, voffB);
        PG8_WAIT_V(6); PG8_BAR;
    } else {
        PG8_STAGE(PG8_SB(0, 0), cB, voffB); PG8_STAGE(PG8_SA(0, 0), cA, voffA); PG8_STAGE(PG8_SB(0, 1), cB + hstepB, voffB); PG8_STAGE(PG8_SA(0, 1), cA + hstepA, voffA);
        if (wr == 1) PG8_BAR;
        PG8_WAIT_V(4); PG8_BAR;
        PG8_STAGE(PG8_SB(1, 0), cB + kstep, voffB); PG8_STAGE(PG8_SA(1, 0), cA + kstep, voffA); PG8_STAGE(PG8_SB(1, 1), cB + hstepB + kstep, voffB);
        PG8_WAIT_V(6); PG8_BAR;
    }
    for (;;) {
        const int nseg = cseg ^ 1; bool has_next; if (cseg == 0) { nxt = cur; has_next = true; } else has_next = S.next((ui >> 1) + 1, nxt);
        const int nt = cseg ? nt1 : nt0;
        const char* nA = has_next ? (const char*)(nseg ? A1 : g.A) + (size_t)nxt.pm * tstepA : cA; const char* nB = has_next ? (const char*)(nseg ? Bt1 : g.Bt) + (size_t)nxt.pn * tstepB : cB;
        for (int t = 0; t < nt; t += 2) {
            const bool last = (t == nt - 2);
            const char* a1 = cA + (size_t)(t + 1) * kstep;
            const char* a2 = last ? nA : cA + (size_t)(t + 2) * kstep; const char* b2 = last ? nB : cB + (size_t)(t + 2) * kstep;
            const char* a3 = a2 + kstep; const char* b3 = b2 + kstep;
            if constexpr (SP2) {
            PG8_LDB(B0, 0, 0); PG8_LDB(B1, 0, 1); PG8_SCHED; PG8_LDA(At, 0, 0); PG8_STAGE(PG8_SA(1, 1), a1 + hstepA, voffA);
            PG8_WAIT_V(8); PG8_WAIT_L(0); PG8_BAR; PG8_MMA(0, 0, At, B0); PG8_MMA(0, 1, At, B1); PG8_BAR; PG8_SCHED;
            PG8_LDA(At, 0, 1); PG8_STAGE(PG8_SB(0, 0), b2, voffB); PG8_STAGE(PG8_SB(0, 1), b2 + hstepB, voffB); PG8_STAGE(PG8_SA(0, 0), a2, voffA);
            PG8_WAIT_V(8); PG8_WAIT_L(0); PG8_BAR; PG8_MMA(1, 0, At, B0); PG8_MMA(1, 1, At, B1); PG8_BAR; PG8_SCHED;
            PG8_LDB(B0, 1, 0); PG8_LDB(B1, 1, 1); PG8_SCHED; PG8_LDA(At, 1, 0); PG8_STAGE(PG8_SA(0, 1), a2 + hstepA, voffA);
            PG8_WAIT_V(8); PG8_WAIT_L(0); PG8_BAR; PG8_MMA(0, 0, At, B0); PG8_MMA(0, 1, At, B1); PG8_BAR; PG8_SCHED;
            PG8_LDA(At, 1, 1); PG8_STAGE(PG8_SB(1, 0), b3, voffB); PG8_STAGE(PG8_SB(1, 1), b3 + hstepB, voffB); PG8_STAGE(PG8_SA(1, 0), a3, voffA);
            PG8_WAIT_V(8); PG8_WAIT_L(0); PG8_BAR; PG8_MMA(1, 0, At, B0); PG8_MMA(1, 1, At, B1); PG8_BAR; PG8_SCHED;
            } else {
            PG8_LDB(B0, 0, 0); PG8_SCHED; PG8_LDA(At, 0, 0); PG8_STAGE(PG8_SA(1, 1), a1 + hstepA, voffA);
            PG8_WAIT_L(8); PG8_BAR; PG8_WAIT_L(0); PG8_MMA(0, 0, At, B0); PG8_BAR; PG8_SCHED;
            PG8_LDB(B1, 0, 1); PG8_STAGE(PG8_SB(0, 0), b2, voffB);
            PG8_BAR; PG8_WAIT_L(0); PG8_MMA(0, 1, At, B1); PG8_BAR;
            PG8_LDA(At, 0, 1); PG8_STAGE(PG8_SA(0, 0), a2, voffA);
            PG8_BAR; PG8_WAIT_L(0); PG8_MMA(1, 0, At, B0); PG8_BAR; PG8_SCHED;
            PG8_STAGE(PG8_SB(0, 1), b2 + hstepB, voffB);
            PG8_WAIT_V(6); PG8_BAR; PG8_MMA(1, 1, At, B1); PG8_BAR;
            PG8_LDB(B0, 1, 0); PG8_SCHED; PG8_LDA(At, 1, 0); PG8_STAGE(PG8_SA(0, 1), a2 + hstepA, voffA);
            PG8_WAIT_L(8); PG8_BAR; PG8_WAIT_L(0); PG8_MMA(0, 0, At, B0); PG8_BAR; PG8_SCHED;
            PG8_LDB(B1, 1, 1); PG8_STAGE(PG8_SB(1, 0), b3, voffB);
            PG8_BAR; PG8_WAIT_L(0); PG8_MMA(0, 1, At, B1); PG8_BAR;
            PG8_LDA(At, 1, 1); PG8_STAGE(PG8_SA(1, 0), a3, voffA);
            PG8_BAR; PG8_WAIT_L(0); PG8_MMA(1, 0, At, B0); PG8_BAR; PG8_SCHED;
            PG8_STAGE(PG8_SB(1, 1), b3 + hstepB, voffB);
            PG8_WAIT_V(6); PG8_BAR; PG8_MMA(1, 1, At, B1); PG8_BAR;
            }
        }
        if constexpr (ALIGN_EPI) { if (wr == 0) PG8_BAR; }
        if (cseg == 0) E.mid(acc, cur, wr, wc, fr, fq); else E(acc, cur, wr, wc, fr, fq);
        if (!has_next) break;
        if (cseg == 1) {
#pragma unroll
        for (int a = 0; a < 2; ++a)
#pragma unroll
            for (int b = 0; b < 2; ++b)
#pragma unroll
                for (int m = 0; m < 4; ++m)
#pragma unroll
                    for (int n = 0; n < 2; ++n) acc[a][b][m][n] = (f32x4){0.f, 0.f, 0.f, 0.f};
        }
        cur = nxt; cA = nA; cB = nB; ++ui; cseg = nseg;
        if constexpr (ALIGN_EPI) { if (wr == 1) PG8_BAR; }
    }
    PG8_WAIT_V(0);
    if constexpr (!ALIGN_EPI) { if (wr == 0) PG8_BAR; }
    PG8_BAR;
#undef PG8_SA
#undef PG8_SB
#undef PG8_STAGE
#undef PG8_LDA
#undef PG8_LDB
#undef PG8_MMA
#undef PG8_WAIT_V
#undef PG8_WAIT_L
#undef PG8_BAR
#undef PG8_SCHED
}
}
#ifndef PHM
#define PHM 255
#endif
#ifndef PROBE_DUP
#define PROBE_DUP 0
#endif
#ifndef P1_WGM
#define P1_WGM 8
#endif
namespace mk {
__device__ __forceinline__ int fresh_tid() { int t = threadIdx.x; asm volatile("" : "+v"(t)); return t; }
using pg8::bf16_t; using pg8::f32x4; using pg8::u32x4; using pg8::Unit;
#define LAS __attribute__((address_space(3)))
typedef short bf16x8 __attribute__((ext_vector_type(8)));
typedef float f32x16 __attribute__((ext_vector_type(16)));
typedef short s16x4 __attribute__((ext_vector_type(4)));
typedef short v4i16_t __attribute__((ext_vector_type(4)));

constexpr int NB = 8, S_ = 4096, D_ = 1024, M_ = NB * S_, IN_ = 3584, NGATE = 2048, NCAT = IN_ + NGATE, FF = 4096, POOL = 512, DEPTH = 2;
constexpr float EPS = 1e-6f, LOG2E = 1.4426950408889634f;
constexpr size_t MiB = 1u << 20;
constexpr int QLD = 1152, GLD = 2176, ULD = 640;
constexpr size_t WS_RS = 1 * MiB;
constexpr size_t WS_W = 3 * MiB;
constexpr size_t WO_CAT = 0, WO_COMB = (size_t)NCAT * 1024, WO_BA = WO_COMB + 1024 * 512, WO_OUT = WO_BA + 1024 * 1024, WO_UP = WO_OUT + 1024 * 1024, WO_DOWN = WO_UP + 4096 * 1024;
constexpr size_t WS_XBF = 35 * MiB;
constexpr size_t WS_U = 107 * MiB;
constexpr size_t WS_Q = 147 * MiB;
constexpr size_t WS_K = 219 * MiB;
constexpr size_t WS_V = 291 * MiB;
constexpr size_t WS_G = 363 * MiB;
constexpr size_t WS_YP = 499 * MiB;
constexpr size_t WS_MRG = WS_K;
constexpr size_t WS_H = WS_U;
constexpr size_t WS_COMB1 = 501 * MiB;
constexpr size_t WS_END = 503 * MiB;
constexpr size_t DO_YP = 0, DO_W0 = 80 * MiB;
constexpr int LDS_BYTES = 147456;
constexpr int HLD = FF + 128;  static_assert(WS_H + (size_t)M_ * HLD * 2 <= WS_YP && WS_G + (size_t)M_ * GLD * 2 <= WS_YP, "ws map");

__device__ __forceinline__ unsigned pk2(float lo, float hi) { return pg8::cvt_pk_bf16(lo, hi); }
__device__ __forceinline__ float bflo(unsigned w) { return __uint_as_float(w << 16); }
__device__ __forceinline__ float bfhi(unsigned w) { return __uint_as_float(w & 0xffff0000u); }
__device__ __forceinline__ float wave_sum(float v) {
#pragma unroll
    for (int o = 1; o < 64; o <<= 1) v += __shfl_xor(v, o);
    return v;
}
__device__ __forceinline__ float wave_max(float v) {
#pragma unroll
    for (int o = 1; o < 64; o <<= 1) v = fmaxf(v, __shfl_xor(v, o));
    return v;
}
__device__ __forceinline__ float rstd_row(const float* RS, int row, int fq) {
    const f32x4 v = *(const f32x4*)(RS + (size_t)row * 16 + 4 * fq);
    float s = (v[0] + v[1]) + (v[2] + v[3]);
    s += __shfl_xor(s, 16); s += __shfl_xor(s, 32);
    return rsqrtf(s * (1.0f / 1024.0f) + EPS);
}
typedef float f32x2 __attribute__((ext_vector_type(2)));
__device__ __forceinline__ float msq_row(const float* RS, int row, int fq) {
    const f32x4 v = *(const f32x4*)(RS + (size_t)row * 16 + 4 * fq);
    float s = (v[0] + v[1]) + (v[2] + v[3]);
    s += __shfl_xor(s, 16); s += __shfl_xor(s, 32);
    return s * (1.0f / 1024.0f) + EPS;
}
__device__ __forceinline__ float sigmoidf_(float z) { return __builtin_amdgcn_rcpf(1.0f + __builtin_amdgcn_exp2f(-z * LOG2E)); }

struct EpiIn {
    static constexpr bool PERM = true, AFTER_DRAIN = false;
    bf16_t *U, *Q, *K, *V, *G; const float* RS; const float* gq; const float* gk; const float* bgate;
    __device__ __forceinline__ void operator()(const f32x4 (&acc)[2][2][4][2], const Unit& u, int wr, int wc, int fr, int fq) const {
        const int row0 = u.pm * 256 + wr * 64 + fr, pn = u.pn;
        if (pn >= 2 && pn < 10) {
            const bool isq = pn < 6; bf16_t* base = isq ? Q : K; const int colt = (pn - (isq ? 2 : 6)) * 256 + 64 * wc + 8 * fq;
            const float* g = isq ? gq : gk; const float sc = isq ? 0.125f * LOG2E : 1.0f;
            f32x4 gv[2][2];
#pragma unroll
            for (int bj = 0; bj < 2; ++bj)
#pragma unroll
                for (int n = 0; n < 2; ++n) gv[bj][n] = *(const f32x4*)(g + 32 * bj + 8 * fq + 4 * n) * sc;
#pragma unroll
            for (int ai = 0; ai < 2; ++ai)
#pragma unroll
                for (int m = 0; m < 4; ++m) {
                    const int row = row0 + ai * 128 + m * 16; const float ir2 = msq_row(RS, row, fq);
                    f32x2 s2 = {0.f, 0.f};
#pragma unroll
                    for (int bj = 0; bj < 2; ++bj)
#pragma unroll
                        for (int n = 0; n < 2; ++n) { const f32x4 a = acc[ai][bj][m][n]; const f32x2 lo = {a[0], a[1]}, hi2 = {a[2], a[3]}; s2 = lo * lo + s2; s2 = hi2 * hi2 + s2; }
                    float ss = s2[0] + s2[1];
                    ss += __shfl_xor(ss, 16); ss += __shfl_xor(ss, 32);
                    const float rn = rsqrtf(ss * (1.0f / 64.0f) + EPS * ir2);
                    const f32x2 rn2 = {rn, rn};
                    bf16_t* rowp = base + (size_t)row * QLD + colt;
#pragma unroll
                    for (int bj = 0; bj < 2; ++bj) {
                        const f32x4 a0 = acc[ai][bj][m][0], a1 = acc[ai][bj][m][1], g0 = gv[bj][0], g1 = gv[bj][1];
                        const f32x2 p0 = (f32x2){a0[0], a0[1]} * ((f32x2){g0[0], g0[1]} * rn2), p1 = (f32x2){a0[2], a0[3]} * ((f32x2){g0[2], g0[3]} * rn2);
                        const f32x2 p2 = (f32x2){a1[0], a1[1]} * ((f32x2){g1[0], g1[1]} * rn2), p3 = (f32x2){a1[2], a1[3]} * ((f32x2){g1[2], g1[3]} * rn2);
                        u32x4 w; w.x = pk2(p0[0], p0[1]); w.y = pk2(p1[0], p1[1]); w.z = pk2(p2[0], p2[1]); w.w = pk2(p3[0], p3[1]);
                        __builtin_nontemporal_store(w, (u32x4*)(rowp + 32 * bj)); }
                }
        } else {
            bf16_t* base; int ld, colt; bool sg = false;
            if (pn < 2) { base = U; ld = ULD; colt = pn * 256; } else if (pn < 14) { base = V; ld = QLD; colt = (pn - 10) * 256; } else { base = G; ld = GLD; colt = (pn - 14) * 256; sg = true; }
            const int col0 = colt + wc * 32 + 8 * fq;
            f32x4 bv[2][2];
#pragma unroll
            for (int bj = 0; bj < 2; ++bj)
#pragma unroll
                for (int n = 0; n < 2; ++n) bv[bj][n] = sg ? *(const f32x4*)(bgate + col0 + bj * 128 + 4 * n) * (-LOG2E) : (f32x4){0.f, 0.f, 0.f, 0.f};
#pragma unroll
            for (int ai = 0; ai < 2; ++ai)
#pragma unroll
                for (int m = 0; m < 4; ++m) {
                    const int row = row0 + ai * 128 + m * 16; const float r = rstd_row(RS, row, fq) * (sg ? -LOG2E : 1.0f);
                    const f32x2 r2 = {r, r}, one2 = {1.0f, 1.0f};
                    bf16_t* rowp = base + (size_t)row * ld + col0;
#pragma unroll
                    for (int bj = 0; bj < 2; ++bj) {
                        const f32x4 a0 = acc[ai][bj][m][0], a1 = acc[ai][bj][m][1], b0 = bv[bj][0], b1 = bv[bj][1];
                        f32x2 p0 = (f32x2){a0[0], a0[1]} * r2 + (f32x2){b0[0], b0[1]}, p1 = (f32x2){a0[2], a0[3]} * r2 + (f32x2){b0[2], b0[3]};
                        f32x2 p2 = (f32x2){a1[0], a1[1]} * r2 + (f32x2){b1[0], b1[1]}, p3 = (f32x2){a1[2], a1[3]} * r2 + (f32x2){b1[2], b1[3]};
                        if (sg) {
#define MK_SG(p) do { p[0] = __builtin_amdgcn_exp2f(p[0]); p[1] = __builtin_amdgcn_exp2f(p[1]); p = p + one2; p[0] = __builtin_amdgcn_rcpf(p[0]); p[1] = __builtin_amdgcn_rcpf(p[1]); } while (0)
                            MK_SG(p0); MK_SG(p1); MK_SG(p2); MK_SG(p3);
#undef MK_SG
                        }
                        u32x4 w; w.x = pk2(p0[0], p0[1]); w.y = pk2(p1[0], p1[1]); w.z = pk2(p2[0], p2[1]); w.w = pk2(p3[0], p3[1]);
                        __builtin_nontemporal_store(w, (u32x4*)(rowp + bj * 128)); }
                }
        }
    }
};
struct EpiMerge2 {
    static constexpr bool PERM = true, AFTER_DRAIN = false;
    const bf16_t* G; bf16_t* MRG;
    __device__ __forceinline__ void mid(f32x4 (&acc)[2][2][4][2], const Unit& u, int wr, int wc, int fr, int fq) const {
        const int row0 = u.pm * 256 + wr * 64 + fr, col0 = u.pn * 256 + wc * 32 + 8 * fq;
#pragma unroll
        for (int ai = 0; ai < 2; ++ai)
#pragma unroll
            for (int m = 0; m < 4; ++m) {
                const int row = row0 + ai * 128 + m * 16;
#pragma unroll
                for (int bj = 0; bj < 2; ++bj) {
                    const bf16_t* gp = G + (size_t)row * GLD + col0 + bj * 128;
                    const u32x4 g0 = *(const u32x4*)gp, g1 = *(const u32x4*)(gp + 1024);
#define MK_RT(a, b) ((a) * __builtin_amdgcn_rcpf(fmaxf((b), 1e-30f)))
                    f32x4& v0 = acc[ai][bj][m][0]; f32x4& v1 = acc[ai][bj][m][1];
                    v0[0] *= MK_RT(bflo(g0.x), bflo(g1.x)); v0[1] *= MK_RT(bfhi(g0.x), bfhi(g1.x)); v0[2] *= MK_RT(bflo(g0.y), bflo(g1.y)); v0[3] *= MK_RT(bfhi(g0.y), bfhi(g1.y));
                    v1[0] *= MK_RT(bflo(g0.z), bflo(g1.z)); v1[1] *= MK_RT(bfhi(g0.z), bfhi(g1.z)); v1[2] *= MK_RT(bflo(g0.w), bflo(g1.w)); v1[3] *= MK_RT(bfhi(g0.w), bfhi(g1.w));
#undef MK_RT
                }
            }
    }
    __device__ __forceinline__ void operator()(const f32x4 (&acc)[2][2][4][2], const Unit& u, int wr, int wc, int fr, int fq) const {
        const int row0 = u.pm * 256 + wr * 64 + fr, col0 = u.pn * 256 + wc * 32 + 8 * fq;
#pragma unroll
        for (int ai = 0; ai < 2; ++ai)
#pragma unroll
            for (int m = 0; m < 4; ++m) {
                const int row = row0 + ai * 128 + m * 16;
#pragma unroll
                for (int bj = 0; bj < 2; ++bj) {
                    const u32x4 gw = *(const u32x4*)(G + (size_t)row * GLD + 1024 + col0 + bj * 128);
                    f32x4 v0 = acc[ai][bj][m][0], v1 = acc[ai][bj][m][1];
                    v0[0] *= bflo(gw.x); v0[1] *= bfhi(gw.x); v0[2] *= bflo(gw.y); v0[3] *= bfhi(gw.y);
                    v1[0] *= bflo(gw.z); v1[1] *= bfhi(gw.z); v1[2] *= bflo(gw.w); v1[3] *= bfhi(gw.w);
                    u32x4 w; w.x = pk2(v0[0], v0[1]); w.y = pk2(v0[2], v0[3]); w.z = pk2(v1[0], v1[1]); w.w = pk2(v1[2], v1[3]);
                    *(u32x4*)(MRG + (size_t)row * QLD + col0 + bj * 128) = w; }
            }
    }
};
struct EpiResid {
    static constexpr bool PERM = true, AFTER_DRAIN = false;
    float* out; bf16_t* xbf; float* RS; int wr_aux;
    __device__ __forceinline__ void operator()(const f32x4 (&acc)[2][2][4][2], const Unit& u, int wr, int wc, int fr, int fq) const {
        const int row0 = u.pm * 256 + wr * 64 + fr, col0 = u.pn * 256 + wc * 32 + 8 * fq;
#pragma unroll
        for (int ai = 0; ai < 2; ++ai)
#pragma unroll
            for (int m = 0; m < 4; ++m) {
                const int row = row0 + ai * 128 + m * 16; float ss = 0.f;
#pragma unroll
                for (int bj = 0; bj < 2; ++bj) {
                    const size_t off = (size_t)row * 1024 + col0 + bj * 128, xoff = (size_t)row * QLD + col0 + bj * 128;
                    const u32x4 xw = *(const u32x4*)(xbf + xoff);
                    f32x4 v0 = acc[ai][bj][m][0], v1 = acc[ai][bj][m][1];
                    v0[0] += bflo(xw.x); v0[1] += bfhi(xw.x); v0[2] += bflo(xw.y); v0[3] += bfhi(xw.y);
                    v1[0] += bflo(xw.z); v1[1] += bfhi(xw.z); v1[2] += bflo(xw.w); v1[3] += bfhi(xw.w);
                    if (wr_aux) {
                        const f32x4 q0 = v0 * v0, q1 = v1 * v1; ss += ((q0[0] + q0[1]) + (q0[2] + q0[3])) + ((q1[0] + q1[1]) + (q1[2] + q1[3]));
                        u32x4 w; w.x = pk2(v0[0], v0[1]); w.y = pk2(v0[2], v0[3]); w.z = pk2(v1[0], v1[1]); w.w = pk2(v1[2], v1[3]);
                        *(u32x4*)(xbf + xoff) = w;
                    } else { *(f32x4*)(out + off) = v0; *(f32x4*)(out + off + 4) = v1; }
                }
                if (wr_aux) { ss += __shfl_xor(ss, 16); ss += __shfl_xor(ss, 32); if (fq == 0) RS[(size_t)row * 16 + u.pn * 4 + wc] = ss; }
            }
    }
};
struct EpiNull {
    static constexpr bool PERM = true, AFTER_DRAIN = false;
    __device__ __forceinline__ void operator()(const f32x4 (&acc)[2][2][4][2], const Unit& u, int wr, int wc, int fr, int fq) const {
#pragma unroll
        for (int ai = 0; ai < 2; ++ai)
#pragma unroll
            for (int bj = 0; bj < 2; ++bj)
#pragma unroll
                for (int m = 0; m < 4; ++m) asm volatile("" :: "v"(acc[ai][bj][m][0]), "v"(acc[ai][bj][m][1]));
    }
};
template <int NORS> struct EpiUpT {
    static constexpr bool PERM = true, AFTER_DRAIN = false;
    bf16_t* H; const float* RS;
    __device__ __forceinline__ void operator()(const f32x4 (&acc)[2][2][4][2], const Unit& u, int wr, int wc, int fr, int fq) const {
        const int row0 = u.pm * 256 + wr * 64 + fr, col0 = u.pn * 256 + wc * 32 + 8 * fq;
#pragma unroll
        for (int ai = 0; ai < 2; ++ai)
#pragma unroll
            for (int m = 0; m < 4; ++m) {
                const int row = row0 + ai * 128 + m * 16; const float r = NORS ? 1.0f : rstd_row(RS, row, fq);
                const f32x2 rr = {r * r, r * r};
#pragma unroll
                for (int bj = 0; bj < 2; ++bj) {
                    const f32x4 a0 = acc[ai][bj][m][0], a1 = acc[ai][bj][m][1];
#define MK_R2(x, y) (((f32x2){x, y} * (f32x2){fmaxf(x, 0.f), fmaxf(y, 0.f)}) * rr)
                    const f32x2 p0 = MK_R2(a0[0], a0[1]), p1 = MK_R2(a0[2], a0[3]), p2 = MK_R2(a1[0], a1[1]), p3 = MK_R2(a1[2], a1[3]);
#undef MK_R2
                    u32x4 w; w.x = pk2(p0[0], p0[1]); w.y = pk2(p1[0], p1[1]); w.z = pk2(p2[0], p2[1]); w.w = pk2(p3[0], p3[1]);
                    __builtin_nontemporal_store(w, (u32x4*)(H + (size_t)row * HLD + col0 + bj * 128)); }
            }
    }
};
typedef EpiUpT<0> EpiUp;
__device__ __forceinline__ int qk_perm_row(int n) {
    if (n < 512 || n >= 2560) return n;
    const int c = n - 512; return 512 + (c & ~255) + 128 * ((c >> 5) & 1) + 32 * ((c >> 6) & 3) + (c & 31);
}
__device__ __forceinline__ void transpose_item(const float* W, int K, int N, bf16_t* WT, int row_off, const float* gk, bool permqk, LAS float* scr, int item, int lane) {
    const int nblk = N / 64, kb = item / nblk, nb = item % nblk, k0 = 64 * kb, n0 = 64 * nb, kr = lane >> 4, nc = lane & 15;
    f32x4 v[16];
#pragma unroll
    for (int i = 0; i < 16; ++i) v[i] = *(const f32x4*)(W + (size_t)(k0 + 4 * i + kr) * N + n0 + 4 * nc);
    if (gk) {
#pragma unroll
        for (int i = 0; i < 16; ++i) v[i] = v[i] * gk[k0 + 4 * i + kr];
    }
#pragma unroll
    for (int i = 0; i < 16; ++i)
#pragma unroll
        for (int e = 0; e < 4; ++e) scr[(4 * nc + e) * 65 + 4 * i + kr] = v[i][e];
    asm volatile("s_waitcnt lgkmcnt(0)" ::: "memory");
    const int c = lane & 7;
#pragma unroll
    for (int j = 0; j < 8; ++j) { const int n = (lane >> 3) + 8 * j; const LAS float* s = scr + n * 65 + 8 * c;
        u32x4 o; o.x = pk2(s[0], s[1]); o.y = pk2(s[2], s[3]); o.z = pk2(s[4], s[5]); o.w = pk2(s[6], s[7]);
        const int dr = permqk ? qk_perm_row(n0 + n) : (n0 + n);
        *(u32x4*)(WT + (size_t)(row_off + dr) * K + k0 + 8 * c) = o; }
    asm volatile("s_waitcnt lgkmcnt(0)" ::: "memory");
}

struct Args { const float* in[17]; float* out; unsigned char* ws; };

__device__ __forceinline__ void p0_phase(const Args& a, int l, LAS unsigned char* lds, int vcu, int G) {
    const int tid = fresh_tid(), lane = tid & 63, wave = __builtin_amdgcn_readfirstlane(tid >> 6);
    LAS float* scr = (LAS float*)(lds + wave * 16640);
    const int gw = vcu * 8 + wave, NGW = G * 8;
    bf16_t* Wb = l ? (bf16_t*)(a.ws + WS_W) : (bf16_t*)((unsigned char*)a.out + DO_W0);
    if (blockIdx.x == 0 && tid < 16) ((unsigned*)a.ws)[64 * tid] = 0u;
    const float* g_mix = a.in[1] + (size_t)l * 1024; const float* w_in = a.in[2] + (size_t)l * 1024 * IN_;
    const float* w_grp = a.in[3] + (size_t)l * 4 * 128 * 128; const float* pscale = a.in[4] + (size_t)l * 512;
    const float* w_bp = a.in[9] + (size_t)l * 512 * 1024; const float* w_ba = a.in[10] + (size_t)l * 1024 * 1024;
    const float* w_gate = a.in[11] + (size_t)l * 1024 * NGATE; const float* w_out = a.in[13] + (size_t)l * 1024 * 1024;
    const float* g_ffn = a.in[14] + (size_t)l * 1024; const float* w_up = a.in[15] + (size_t)l * 1024 * FF; const float* w_down = a.in[16] + (size_t)l * FF * 1024;
    constexpr int I_IN = 16 * (IN_ / 64), I_GATE = 16 * (NGATE / 64), I_BA = 16 * 16, I_OUT = 16 * 16, I_UP = 16 * (FF / 64), I_DOWN = 64 * 16;
    constexpr int NITEMS = I_IN + I_GATE + I_BA + I_OUT + I_UP + I_DOWN;
    for (int it = gw; it < NITEMS; it += NGW) {
        int r = it;
        if (r < I_IN) { transpose_item(w_in, 1024, IN_, Wb + WO_CAT, 0, g_mix, true, scr, r, lane); continue; } r -= I_IN;
        if (r < I_GATE) { transpose_item(w_gate, 1024, NGATE, Wb + WO_CAT, IN_, g_mix, false, scr, r, lane); continue; } r -= I_GATE;
        if (r < I_BA) { transpose_item(w_ba, 1024, 1024, Wb + WO_BA, 0, nullptr, false, scr, r, lane); continue; } r -= I_BA;
        if (r < I_OUT) { transpose_item(w_out, 1024, 1024, Wb + WO_OUT, 0, nullptr, false, scr, r, lane); continue; } r -= I_OUT;
        if (r < I_UP) { transpose_item(w_up, 1024, FF, Wb + WO_UP, 0, g_ffn, false, scr, r, lane); continue; } r -= I_UP;
        transpose_item(w_down, FF, 1024, Wb + WO_DOWN, 0, nullptr, false, scr, r, lane);
    }
    __syncthreads();
    for (int it = vcu; it < 64; it += G) {
        const int g = it >> 4, cb = (it >> 1) & 7, n = (it & 1) * 512 + tid;
        LAS float* wl = (LAS float*)lds;
#pragma unroll
        for (int j = 0; j < 4; ++j) { const int e = tid + 512 * j, cc = e >> 7, d = e & 127; wl[e] = w_grp[((size_t)g * 128 + cb * 16 + cc) * 128 + d] * pscale[g * 128 + d]; }
        __syncthreads();
        const float* bp = w_bp + (size_t)(g * 128) * 1024 + n;
        float acc[16];
#pragma unroll
        for (int cc = 0; cc < 16; ++cc) acc[cc] = 0.f;
#pragma unroll 8
        for (int d = 0; d < 128; ++d) { const float bv = bp[(size_t)d * 1024];
#pragma unroll
            for (int cc = 0; cc < 16; ++cc) acc[cc] += wl[cc * 128 + d] * bv; }
        u32x4 o0, o1;
        o0.x = pk2(acc[0], acc[1]); o0.y = pk2(acc[2], acc[3]); o0.z = pk2(acc[4], acc[5]); o0.w = pk2(acc[6], acc[7]);
        o1.x = pk2(acc[8], acc[9]); o1.y = pk2(acc[10], acc[11]); o1.z = pk2(acc[12], acc[13]); o1.w = pk2(acc[14], acc[15]);
        bf16_t* op = (bf16_t*)(a.ws + (l ? WS_COMB1 : WS_YP)) + (size_t)n * 1024 + g * 128 + cb * 16;
        *(u32x4*)op = o0; *(u32x4*)(op + 8) = o1;
        __syncthreads();
    }
    if (l == 0) {
        const float* x = a.in[0]; bf16_t* xbf = (bf16_t*)(a.ws + WS_XBF); float* RS = (float*)(a.ws + WS_RS);
        for (int m = gw; m < M_; m += NGW) {
            const f32x4* xr = (const f32x4*)(x + (size_t)m * 1024) + lane; f32x4 v[4]; float s = 0.f;
#pragma unroll
            for (int j = 0; j < 4; ++j) { v[j] = xr[64 * j]; const f32x4 q = v[j] * v[j]; s += (q[0] + q[1]) + (q[2] + q[3]); }
            s = wave_sum(s);
            unsigned long long* o8 = (unsigned long long*)(xbf + (size_t)m * QLD) + lane;
#pragma unroll
            for (int j = 0; j < 4; ++j) o8[64 * j] = (unsigned long long)pk2(v[j][0], v[j][1]) | ((unsigned long long)pk2(v[j][2], v[j][3]) << 32);
            if (lane < 16) RS[(size_t)m * 16 + lane] = lane == 0 ? s : 0.f;
        }
    }
}

template <int W> __device__ __forceinline__ void mix_item(const bf16_t* U, bf16_t* YP, int blk, int g, int lane) {
    const int sub = lane >> 4, ch = lane & 15, row0 = blk * 32 + sub * 8, t0 = row0 & (S_ - 1);
    const bf16_t* p = U + (size_t)row0 * ULD + g * 128 + ch * 8;
    u32x4 v[W + 7];
#pragma unroll
    for (int i = 0; i < W + 7; ++i) { const int dt = i - (W - 1); v[i] = (t0 + dt >= 0) ? *(const u32x4*)(p + (ptrdiff_t)dt * ULD) : (u32x4){0u, 0u, 0u, 0u}; }
#pragma unroll
    for (int r = 0; r < 8; ++r) {
        float s0 = 0.f, s1 = 0.f, s2 = 0.f, s3 = 0.f, s4 = 0.f, s5 = 0.f, s6 = 0.f, s7 = 0.f;
#pragma unroll
        for (int j = 0; j < W; ++j) { const u32x4 x = v[r + W - 1 - j];
            s0 += bflo(x.x); s1 += bfhi(x.x); s2 += bflo(x.y); s3 += bfhi(x.y); s4 += bflo(x.z); s5 += bfhi(x.z); s6 += bflo(x.w); s7 += bfhi(x.w); }
        const int t = t0 + r; const float inv = 1.0f / (float)((t + 1 < W) ? (t + 1) : W); const u32x4 self = v[r + W - 1];
        u32x4 o; o.x = pk2(s0 * inv - bflo(self.x), s1 * inv - bfhi(self.x)); o.y = pk2(s2 * inv - bflo(self.y), s3 * inv - bfhi(self.y));
        o.z = pk2(s4 * inv - bflo(self.z), s5 * inv - bfhi(self.z)); o.w = pk2(s6 * inv - bflo(self.w), s7 * inv - bfhi(self.w));
        *(u32x4*)(YP + (size_t)(row0 + r) * QLD + g * 128 + ch * 8) = o;
    }
}
__device__ __forceinline__ void mix_phase(const bf16_t* U, bf16_t* YP, int vcu, int G) {
    const int tid = fresh_tid(), lane = tid & 63, wave = __builtin_amdgcn_readfirstlane(tid >> 6);
    for (int it = vcu * 8 + wave; it < (M_ / 32) * 4; it += G * 8) {
        const int g = it & 3, blk = it >> 2;
        if (g == 0) mix_item<2>(U, YP, blk, 0, lane); else if (g == 1) mix_item<4>(U, YP, blk, 1, lane); else if (g == 2) mix_item<8>(U, YP, blk, 2, lane); else mix_item<16>(U, YP, blk, 3, lane);
    }
}

__device__ __forceinline__ int crow(int r, int hi) { return (r & 3) + 8 * (r >> 2) + 4 * hi; }
__device__ __forceinline__ s16x4 vtr(const LAS unsigned char* p) { return __builtin_bit_cast(s16x4, __builtin_amdgcn_ds_read_tr16_b64_v4i16((LAS v4i16_t*)p)); }
constexpr int AT_STG = 32768, AT_VOF = 16384, AT_WSF = 3 * AT_STG;
static_assert(AT_WSF + 2048 <= 131072 && AT_WSF >= 65536, "attention LDS map");
__device__ __forceinline__ void glds16(const void* gsrc, unsigned lds_dst) { unsigned keep;
    asm volatile("s_mov_b32 %0, m0\n\ts_mov_b32 m0, %2\n\ts_nop 0\n\tglobal_load_lds_dwordx4 %1, off\n\ts_mov_b32 m0, %0" : "=&s"(keep) : "v"(gsrc), "s"(lds_dst) : "memory"); }
#define AT_WAIT_BAR(N) asm volatile("s_waitcnt vmcnt(" #N ") lgkmcnt(0)\n\ts_barrier" ::: "memory")

__device__ __forceinline__ void attn_unit(int b, int h, int qb, const bf16_t* Q, const bf16_t* K, const bf16_t* V, bf16_t* O, const float* gsub, float lam, float oscale, float M2, int kt_lo, LAS unsigned char* lds, int tid, bool do_store = true) {
    const int lane = tid & 63, r32 = lane & 31, hi = lane >> 5, wid = __builtin_amdgcn_readfirstlane(tid >> 6), rg = wid & 3, mp = wid >> 2;
    const size_t rowbase = (size_t)b * S_; const int q0 = qb * 128;
    const bf16_t* Qw = Q + (rowbase + q0 + 32 * rg + r32) * QLD + h * 128 + mp * 64 + hi * 8;
    bf16x8 qr[4];
#pragma unroll
    for (int d0 = 0; d0 < 4; ++d0) qr[d0] = *(const bf16x8*)(Qw + d0 * 16);
    const int NT = 2 * qb + 2, ktmax = 2 * qb + (rg >> 1);
    const float sl2 = __builtin_amdgcn_exp2f(-(float)(h + 1)) * LOG2E;
    const int drow = 8 * wid + (lane >> 4), dch = lane & 15;
    const bf16_t* ks0 = K + (rowbase + (size_t)kt_lo * 64 + drow) * QLD + h * 128 + ((dch ^ (drow & 15)) << 3);
    const bf16_t* ks1 = K + (rowbase + (size_t)kt_lo * 64 + drow + 4) * QLD + h * 128 + ((dch ^ ((drow + 4) & 15)) << 3);
    const bf16_t* vs0 = V + (rowbase + (size_t)kt_lo * 64 + drow) * QLD + h * 128 + ((dch ^ ((drow & 3) << 2)) << 3);
    const bf16_t* vs1 = vs0 + 4 * QLD;
    const unsigned ldsb = (unsigned)(size_t)lds + (unsigned)wid * 2048u;
#define AT_DMA(stage) do { const unsigned d_ = (unsigned)__builtin_amdgcn_readfirstlane((int)(ldsb + (unsigned)(stage) * AT_STG)); \
        glds16(ks0, d_); glds16(ks1, d_ + 1024u); glds16(vs0, d_ + AT_VOF); glds16(vs1, d_ + AT_VOF + 1024u); \
        ks0 += 64 * QLD; ks1 += 64 * QLD; vs0 += 64 * QLD; vs1 += 64 * QLD; } while (0)
    int st_c = 0;
    AT_DMA(0);
    if (kt_lo + 1 < NT) AT_DMA(1);
    asm volatile("" :: "v"(qr[0]), "v"(qr[1]), "v"(qr[2]), "v"(qr[3]));
    f32x16 o[4];
#pragma unroll
    for (int c = 0; c < 4; ++c)
#pragma unroll
        for (int r = 0; r < 16; ++r) o[c][r] = 0.f;
    float l = 0.f;
    int kofs[4], vofs[4];
    { const int q4 = (lane & 15) >> 2, p4 = lane & 3, blk = (lane >> 4) & 1;
#pragma unroll
      for (int d0 = 0; d0 < 4; ++d0) kofs[d0] = r32 * 256 + (((mp * 8 + 2 * d0 + hi) ^ (r32 & 15)) << 4);
#pragma unroll
      for (int c = 0; c < 4; ++c) vofs[c] = AT_VOF + (4 * hi + q4) * 256 + ((((c ^ q4) << 2) | (blk << 1) | (p4 >> 1)) << 4) + 8 * (p4 & 1); }
    const float qposf = (float)(q0 + 32 * rg + r32 - 4 * hi);
    for (int kt = kt_lo; kt < NT; ++kt) {
        if (kt + 1 < NT) AT_WAIT_BAR(4); else AT_WAIT_BAR(0);
        if (kt + 2 < NT) AT_DMA(st_c == 0 ? 2 : st_c - 1);
        if (kt <= ktmax) {
            const LAS unsigned char* sb = lds + st_c * AT_STG;
            f32x16 s0, s1;
#pragma unroll
            for (int r = 0; r < 16; ++r) { s0[r] = -M2; s1[r] = -M2; }
#pragma unroll
            for (int d0 = 0; d0 < 4; ++d0) {
                const bf16x8 a0 = *(const LAS bf16x8*)(sb + kofs[d0]), a1 = *(const LAS bf16x8*)(sb + kofs[d0] + 32 * 256);
                s0 = __builtin_amdgcn_mfma_f32_32x32x16_bf16(a0, qr[d0], s0, 0, 0, 0);
                s1 = __builtin_amdgcn_mfma_f32_32x32x16_bf16(a1, qr[d0], s1, 0, 0, 0);
            }
            s16x4 va[4][2], vc[4][2];
#define AT_VRD(dst, ks) do { _Pragma("unroll") for (int c = 0; c < 4; ++c) { dst[c][0] = vtr(sb + vofs[c] + (ks) * 16 * 256); dst[c][1] = vtr(sb + vofs[c] + (ks) * 16 * 256 + 8 * 256); } } while (0)
#define AT_VMM(src, ks) do { _Pragma("unroll") for (int c = 0; c < 4; ++c) { const bf16x8 vf = (bf16x8){src[c][0][0], src[c][0][1], src[c][0][2], src[c][0][3], src[c][1][0], src[c][1][1], src[c][1][2], src[c][1][3]}; \
                o[c] = __builtin_amdgcn_mfma_f32_32x32x16_bf16(__builtin_bit_cast(bf16x8, pw[ks]), vf, o[c], 0, 0, 0); } } while (0)
            AT_VRD(va, 0);
            __builtin_amdgcn_sched_barrier(0);
            const float dq = qposf - (float)(kt * 64);
            float ls = 0.f;
#pragma unroll
            for (int r = 0; r < 16; ++r) { const float d = dq - (float)((r & 3) + 8 * (r >> 2));
                s0[r] = __builtin_amdgcn_exp2f(__builtin_fmaf(-sl2, __builtin_fabsf(d), s0[r]));
                s1[r] = __builtin_amdgcn_exp2f(__builtin_fmaf(-sl2, __builtin_fabsf(d - 32.0f), s1[r]));
                ls += s0[r] + s1[r]; }
            l += ls;
            u32x4 pw[4];
#pragma unroll
            for (int j = 0; j < 4; ++j) { pw[0][j] = pk2(s0[2 * j], s0[2 * j + 1]); pw[1][j] = pk2(s0[8 + 2 * j], s0[8 + 2 * j + 1]); pw[2][j] = pk2(s1[2 * j], s1[2 * j + 1]); pw[3][j] = pk2(s1[8 + 2 * j], s1[8 + 2 * j + 1]); }
            __builtin_amdgcn_sched_barrier(0);
            AT_VRD(vc, 1); __builtin_amdgcn_sched_barrier(0);
            AT_VMM(va, 0); __builtin_amdgcn_sched_barrier(0);
            AT_VRD(va, 2); __builtin_amdgcn_sched_barrier(0);
            AT_VMM(vc, 1); __builtin_amdgcn_sched_barrier(0);
            AT_VRD(vc, 3); __builtin_amdgcn_sched_barrier(0);
            AT_VMM(va, 2); __builtin_amdgcn_sched_barrier(0);
            AT_VMM(vc, 3); __builtin_amdgcn_sched_barrier(0);
#undef AT_VRD
#undef AT_VMM
        }
        st_c = (st_c == 2) ? 0 : st_c + 1;
    }
    AT_WAIT_BAR(0);
#undef AT_DMA
    l += __shfl_xor(l, 32);
    LAS float* wsf = (LAS float*)(lds + AT_WSF) + wid * 64;
    if (hi == 0) wsf[r32] = l;
    asm volatile("s_waitcnt lgkmcnt(0)" ::: "memory");
#pragma unroll
    for (int r = 0; r < 16; ++r) { const float rl = 1.0f / wsf[crow(r, hi)];
#pragma unroll
        for (int c = 0; c < 4; ++c) o[c][r] *= rl; }
    LAS float* X = (LAS float*)lds + rg * 4096;
    if (mp == 1) {
#pragma unroll
        for (int c = 0; c < 4; ++c)
#pragma unroll
            for (int r = 0; r < 16; ++r) X[crow(r, hi) * 128 + 32 * c + r32] = o[c][r];
    }
    __syncthreads();
    if (mp == 0 && do_store) {
        float gs[4];
#pragma unroll
        for (int c = 0; c < 4; ++c) gs[c] = gsub[32 * c + r32] * oscale;
#pragma unroll
        for (int r = 0; r < 16; ++r) {
            float ss = 0.f;
#pragma unroll
            for (int c = 0; c < 4; ++c) { o[c][r] -= lam * X[crow(r, hi) * 128 + 32 * c + r32]; ss += o[c][r] * o[c][r]; }
            ss += __shfl_xor(ss, 1); ss += __shfl_xor(ss, 2); ss += __shfl_xor(ss, 4); ss += __shfl_xor(ss, 8); ss += __shfl_xor(ss, 16);
            const float rn = rsqrtf(ss * (1.0f / 128.0f) + EPS);
            bf16_t* op = O + (rowbase + q0 + 32 * rg + crow(r, hi)) * QLD + h * 128 + r32;
#pragma unroll
            for (int c = 0; c < 4; ++c) op[32 * c] = (bf16_t)(pk2(o[c][r] * rn * gs[c], 0.f) & 0xffffu);
        }
    }
    __syncthreads();
}

constexpr int AT_ORD = 131072;
constexpr float AT_THR2 = 40.0f;
__device__ __forceinline__ void attn_phase(const Args& a, int l, LAS unsigned char* lds, int bx, int pass = 0, bool do_store = true) {
    const int tid = fresh_tid(), lane = tid & 63;
    const float* gq = a.in[5] + l * 64; const float* gk = a.in[6] + l * 64; const float* lq = a.in[7] + l * 256; const float* gsub = a.in[8] + l * 128;
    const float lambda_init = 0.8f - 0.6f * expf(-0.3f * (float)l);
    const float lam = expf(wave_sum(lq[lane] * lq[64 + lane])) - expf(wave_sum(lq[128 + lane] * lq[192 + lane])) + lambda_init;
    const float M2 = 8.0f * wave_max(fabsf(gq[lane])) * wave_max(fabsf(gk[lane])) * LOG2E;
    const bf16_t* Q = (const bf16_t*)(a.ws + WS_Q); const bf16_t* K = (const bf16_t*)(a.ws + WS_K); const bf16_t* V = (const bf16_t*)(a.ws + WS_V);
    LAS int* ord = (LAS int*)(lds + AT_ORD); LAS int* cst = ord + 256; LAS int* cur = cst + 256;
    unsigned* ctr = (unsigned*)a.ws + 512 * pass;
    int my_lo = 0;
    if (tid < 256) {
        const int h = tid >> 5, qb = tid & 31;
        const float sl2 = __builtin_amdgcn_exp2f(-(float)(h + 1)) * LOG2E, Wd = (2.0f * M2 + AT_THR2) / sl2;
        const float x = ((float)(128 * qb - 63) - Wd) * (1.0f / 64.0f);
        my_lo = x > 0.f ? (int)ceilf(x) : 0;
        cst[tid] = ((2 * qb + 2 - my_lo) << 8) | my_lo;
    }
    if (tid < 256) ord[(7 - (tid >> 5)) * 32 + 31 - (tid & 31)] = tid;
    __syncthreads();
    const int xcc = (int)(__builtin_amdgcn_s_getreg((3 << 11) | 20) & 0xFu) & 7;
    for (int qi = 0; qi < 8; ++qi) {
        const int qx = (xcc + qi) & 7;
        for (;;) {
            if (tid == 0) cur[0] = (int)__hip_atomic_fetch_add(ctr + 64 * qx, 1u, __ATOMIC_RELAXED, __HIP_MEMORY_SCOPE_AGENT);
            __syncthreads();
            const int idx = cur[0];
            __syncthreads();
            if (idx >= 256) break;
            const int t = ord[idx], klo = cst[t] & 255;
            attn_unit(qx, t >> 5, t & 31, Q, K, V, (bf16_t*)(a.ws + WS_Q), gsub, lam, 1.0f - lambda_init, M2, klo, lds, tid, do_store);
        }
    }
}

#define XB_TMO      128
#define XB_XCNT(j)  (256  + 64 * (j))
#define XB_XSUB(j)  (1280 + 64 * (j))
#define XB_XGEN(j)  (2304 + 64 * (j))
#define XB_TOP      3328
#define XB_TOPGEN   3392
#define XCD_BAR_WORDS 3456
#define XB_SPIN_CAP (1u << 18)

__device__ __forceinline__ unsigned xb_ld(unsigned* p)              { return __hip_atomic_load(p, __ATOMIC_RELAXED, __HIP_MEMORY_SCOPE_AGENT); }
__device__ __forceinline__ unsigned xb_add(unsigned* p, unsigned v) { return __hip_atomic_fetch_add(p, v, __ATOMIC_RELAXED, __HIP_MEMORY_SCOPE_AGENT); }
__device__ __forceinline__ unsigned xb_xcc_id() { return (unsigned)__builtin_amdgcn_s_getreg((3 << 11) | 20) & 0xFu; }
#define XB_SPIN(cond, bar) do { unsigned _sp = 0; while (cond) { __builtin_amdgcn_s_sleep(1); \
    if ((++_sp & 255u) == 0u) { if (xb_ld(&(bar)[XB_TMO])) break; if (_sp > XB_SPIN_CAP) { atomicAdd(&(bar)[XB_TMO], 1u); break; } } } } while (0)

struct XcdBarrier {
    unsigned* bar; unsigned x;
    volatile __attribute__((address_space(3))) unsigned* st;
};

__device__ __forceinline__ XcdBarrier xcd_barrier_post(unsigned* bar, volatile __attribute__((address_space(3))) unsigned* st) {
    XcdBarrier b; b.bar = bar; b.x = xb_xcc_id(); b.st = st;
    if (threadIdx.x == 0) (void)xb_add(&bar[XB_XCNT(b.x)], 1u);
    return b;
}
__device__ __forceinline__ void xcd_barrier_complete(unsigned* bar, unsigned x, unsigned& nloc, unsigned& nx) {
    const unsigned G = gridDim.x * gridDim.y * gridDim.z;
    unsigned sum, cnt, mine, sp = 0u;
    for (;;) {
        sum = 0u; cnt = 0u; mine = 0u;
#pragma unroll
        for (unsigned j = 0; j < 16; ++j) { const unsigned c = xb_ld(&bar[XB_XCNT(j)]); sum += c; cnt += (c > 0u) ? 1u : 0u; mine = (j == x) ? c : mine; }
        if (sum == G) break;
        __builtin_amdgcn_s_sleep(1);
        if ((++sp & 255u) == 0u) { if (xb_ld(&bar[XB_TMO])) break; if (sp > XB_SPIN_CAP) { atomicAdd(&bar[XB_TMO], 1u); break; } }
    }
    nloc = mine > 0u ? mine : 1u; nx = cnt > 0u ? cnt : 1u;
}

__device__ __forceinline__ void xcd_barrier(const XcdBarrier& b) {
    asm volatile("s_waitcnt vmcnt(0)" ::: "memory");
    __syncthreads();
    if (threadIdx.x == 0) {
        unsigned* bar = b.bar;
        __builtin_amdgcn_s_waitcnt(0);
        unsigned nloc = b.st[0], nx = b.st[1];
        if (nloc == 0u) { xcd_barrier_complete(bar, b.x, nloc, nx); b.st[0] = nloc; b.st[1] = nx; }
        const unsigned old = xb_add(&bar[XB_XSUB(b.x)], 1u);
        const unsigned gen = old / nloc;
        if (old + 1u == (gen + 1u) * nloc) {
            __builtin_amdgcn_fence(__ATOMIC_RELEASE, "agent");
            asm volatile("s_waitcnt vmcnt(0)" ::: "memory");
            const unsigned og = xb_add(&bar[XB_TOP], 1u);
            const unsigned tg = og / nx;
            if (og + 1u == (tg + 1u) * nx) xb_add(&bar[XB_TOPGEN], 1u);
            else XB_SPIN(xb_ld(&bar[XB_TOPGEN]) == tg, bar);
            __builtin_amdgcn_fence(__ATOMIC_ACQUIRE, "agent");
            xb_add(&bar[XB_XGEN(b.x)], 1u);
            asm volatile("s_waitcnt vmcnt(0)" ::: "memory");
        } else {
            XB_SPIN(xb_ld(&bar[XB_XGEN(b.x)]) == gen, bar);
            __builtin_amdgcn_fence(__ATOMIC_ACQUIRE, "agent");
            asm volatile("s_waitcnt vmcnt(0)" ::: "memory");
        }
    }
    __syncthreads();
}

#ifndef STAG_TICKS
#define STAG_TICKS 220
#endif
__device__ __forceinline__ void stagger(int grp) {
    if (grp) { const unsigned long long t0 = __builtin_amdgcn_s_memrealtime(), w = (unsigned long long)grp * STAG_TICKS;
        while (__builtin_amdgcn_s_memrealtime() - t0 < w) __builtin_amdgcn_s_sleep(8); }
}
__global__ void __launch_bounds__(512, 2) fwd(Args a) {
    extern __shared__ __attribute__((aligned(16))) unsigned char lds_raw[];
    LAS unsigned char* lds = (LAS unsigned char*)lds_raw;
    cg::grid_group grid = cg::this_grid();
    const int G = gridDim.x, bx = blockIdx.x, vcu = (G % 8 == 0) ? (bx % 8) * (G / 8) + bx / 8 : bx;
    unsigned char* ws = a.ws;
    bf16_t* Wb; bf16_t* XBF = (bf16_t*)(ws + WS_XBF); float* RS = (float*)(ws + WS_RS);
    bf16_t* Ub = (bf16_t*)(ws + WS_U); bf16_t* Qb = (bf16_t*)(ws + WS_Q); bf16_t* Kb = (bf16_t*)(ws + WS_K); bf16_t* Vb = (bf16_t*)(ws + WS_V);
    bf16_t* Gb = (bf16_t*)(ws + WS_G); bf16_t* YP = (bf16_t*)((unsigned char*)a.out + DO_YP);
    bf16_t* WCOMB;     bf16_t* MRG = (bf16_t*)(ws + WS_MRG); bf16_t* Hb = (bf16_t*)(ws + WS_H);
    unsigned* barw = (unsigned*)ws + 4096;
    if (bx == 0) for (int i = threadIdx.x; i < XCD_BAR_WORDS; i += 512) barw[i] = 0u;
    volatile LAS unsigned* bst = (volatile LAS unsigned*)(lds + 135168);
    if (threadIdx.x < 2) bst[threadIdx.x] = 0u;
    __syncthreads();
    XcdBarrier xbar; xbar.bar = barw; xbar.x = 0; xbar.st = bst;
#define SEAM() xcd_barrier(xbar)
#if PHM & 1
    p0_phase(a, 0, lds, vcu, G);
    p0_phase(a, 1, lds, vcu, G);
#endif
    grid.sync(); xbar = xcd_barrier_post(barw, bst);
    for (int l = 0; l < DEPTH; ++l) {
        Wb = l ? (bf16_t*)(ws + WS_W) : (bf16_t*)((unsigned char*)a.out + DO_W0); WCOMB = (bf16_t*)(ws + (l ? WS_COMB1 : WS_YP));
#if PHM & 2
        {
            pg8::Gemm g{XBF, Wb + WO_CAT, M_, NCAT, 1024, 0, QLD}; pg8::StaticOrder S; S.init(M_, NCAT, G, bx, P1_WGM);
            EpiIn E{Ub, Qb, Kb, Vb, Gb, RS, a.in[5] + l * 64, a.in[6] + l * 64, a.in[12] + (size_t)l * NGATE};
            pg8::gemm_phase<EpiIn, pg8::StaticOrder, true, true>(lds, g, S, E);
#if PROBE_DUP == 2
            SEAM(); pg8::gemm_phase<EpiIn, pg8::StaticOrder, true, true>(lds, g, S, E);
#endif
#if PROBE_DUP == 12
            SEAM(); { EpiNull EN; pg8::gemm_phase<EpiNull, pg8::StaticOrder, true, true>(lds, g, S, EN); }
#endif
        }
#endif
        SEAM();
#if PHM & 4
        mix_phase(Ub, YP, vcu, G);
#if PROBE_DUP == 3
        grid.sync(); mix_phase(Ub, YP, vcu, G);
#endif
#endif
#if PHM & 8
#if PROBE_DUP == 4
        attn_phase(a, l, lds, bx, 1, a.ws == nullptr); grid.sync();
#endif
        attn_phase(a, l, lds, bx, l);
#endif
        SEAM();
#if PHM & 16
        {
            pg8::StaticOrder S; S.init(M_, 1024, G, bx);
            { pg8::Gemm g{YP, WCOMB, M_, 1024, 1024, 512, QLD}; EpiMerge2 E{Gb, MRG}; pg8::gemm_phase2<EpiMerge2, pg8::StaticOrder, true, true>(lds, g, Qb, Wb + WO_BA, 1024, S, E); }
        }
#endif
        SEAM();
#if PHM & 32
        {
            pg8::Gemm g{MRG, Wb + WO_OUT, M_, 1024, 1024, 0, QLD}; pg8::StaticOrder S; S.init(M_, 1024, G, bx);
            EpiResid E{a.out, XBF, RS, 1};
            pg8::gemm_phase<EpiResid, pg8::StaticOrder, true, true>(lds, g, S, E);
        }
        SEAM();
#endif
#if PHM & 64
        {
            pg8::Gemm g{XBF, Wb + WO_UP, M_, FF, 1024, 0, QLD}; pg8::StaticOrder S; S.init(M_, FF, G, bx);
            EpiUp E{Hb, RS};
#if PROBE_DUP == 13
            { pg8::gemm_phase<EpiUp, pg8::StaticOrder, true, true>(lds, g, S, E); SEAM(); }
#elif PROBE_DUP == 14
            { EpiUpT<1> E1{Hb, RS}; pg8::gemm_phase<EpiUpT<1>, pg8::StaticOrder, true, true>(lds, g, S, E1); SEAM(); }
#elif PROBE_DUP == 15
            { EpiNull EN; pg8::gemm_phase<EpiNull, pg8::StaticOrder, true, true>(lds, g, S, EN); SEAM(); }
#endif
            pg8::gemm_phase<EpiUp, pg8::StaticOrder, true, true>(lds, g, S, E);
#if PROBE_DUP == 6
            grid.sync(); pg8::gemm_phase<EpiUp, pg8::StaticOrder, true, true>(lds, g, S, E);
#endif
        }
        SEAM();
#endif
#if PHM & 128
        {
            pg8::Gemm g{Hb, Wb + WO_DOWN, M_, 1024, FF, 0, HLD}; pg8::StaticOrder S; S.init(M_, 1024, G, bx);
            EpiResid E{a.out, XBF, RS, l + 1 < DEPTH ? 1 : 0};
            pg8::gemm_phase<EpiResid, pg8::StaticOrder, true, true>(lds, g, S, E);
        }
#endif
        if (l + 1 < DEPTH) SEAM();
#if PROBE_DUP == 7
        for (int i = 0; i < 10; ++i) SEAM();
#endif
    }
}
}

extern "C" void kernel_launch(void* const* d_in, const int* in_sizes, int n_in, void* d_out, int out_size, void* d_ws, size_t ws_size, hipStream_t stream) {
    static int grid = 0;
    if (grid == 0) {
        if (n_in != 17 || out_size != mk::M_ * mk::D_ || ws_size < mk::WS_END) { fprintf(stderr, "kernel_launch: unexpected shapes (n_in %d, out %d, ws %zu)\n", n_in, out_size, ws_size); grid = -1; return; }
        int dev = 0, cus = 0, per_cu = 0;
        hipGetDevice(&dev);
        hipDeviceGetAttribute(&cus, hipDeviceAttributeMultiprocessorCount, dev);
        if (hipFuncSetAttribute((const void*)mk::fwd, hipFuncAttributeMaxDynamicSharedMemorySize, mk::LDS_BYTES) != hipSuccess) { fprintf(stderr, "kernel_launch: hipFuncSetAttribute failed\n"); grid = -1; return; }
        hipOccupancyMaxActiveBlocksPerMultiprocessor(&per_cu, (const void*)mk::fwd, 512, mk::LDS_BYTES);
        if (per_cu < 1) { fprintf(stderr, "kernel_launch: occupancy query says 0 blocks per CU\n"); per_cu = 1; }
        (void)hipGetLastError();
        grid = cus;
    }
    if (grid < 0) return;
    mk::Args a{};
    for (int i = 0; i < 17; ++i) a.in[i] = (const float*)d_in[i];
    a.out = (float*)d_out; a.ws = (unsigned char*)d_ws;
    void* args[] = {&a};
    hipError_t e = hipLaunchCooperativeKernel((void*)mk::fwd, dim3(grid), dim3(512), args, mk::LDS_BYTES, stream);
    if (e != hipSuccess) fprintf(stderr, "kernel_launch: cooperative launch failed: %s (grid %d)\n", hipGetErrorString(e), grid);
}
```

```cpp
#include <hip/hip_runtime.h>
#include <hip/hip_cooperative_groups.h>
#include <cstdio>
#include <cstdint>
namespace cg = cooperative_groups;
namespace pg8 {
#define PG8_LAS __attribute__((address_space(3)))
typedef unsigned short bf16_t;
typedef short bf16x8 __attribute__((ext_vector_type(8)));
typedef float f32x4 __attribute__((ext_vector_type(4)));
typedef unsigned u32x4 __attribute__((ext_vector_type(4)));
constexpr int BM = 256, BK = 64, HALF = 128, HTB = HALF * BK * 2  , STAGE_BYTES = 8 * HTB, NXCD = 8, WGM = 8;

__host__ __device__ __forceinline__ int lds_byte(int r, int c) { const int st = (r >> 4) * 2 + (c >> 5), rr = r & 15, cc = c & 31, ob = rr * 64 + cc * 2; return st * 1024 + (ob ^ (((ob >> 9) & 1) << 5)); }
__host__ __device__ __forceinline__ void stage_rc(int b, int& R, int& C) { const int st = b / 1024, sb = b % 1024, swz = sb ^ (((sb >> 9) & 1) << 5); R = (st >> 1) * 16 + swz / 64; C = (st & 1) * 32 + (swz % 64) / 2; }
__host__ __device__ __forceinline__ int perm32(int rho) { const int n = rho >> 4, i = rho & 15; return 8 * (i >> 2) + 4 * n + (i & 3); }

struct Unit { int pm, pn; };
struct Gemm { const bf16_t* A; const bf16_t* Bt; int M, N, K; int N_seg0K = 0; int lda = 0; };

struct StaticOrder {
    int nM, nN, nwg, G, c, wgm;
    __host__ __device__ void init(int M, int N, int G_, int c_, int wgm_ = WGM) { nM = M / BM; nN = N / BM; nwg = nM * nN; G = G_; c = c_; wgm = wgm_; }
    __host__ __device__ bool next(int i, Unit& u) const {
        const long L = (long)i * G + c; if (L >= nwg) return false;
        int wgid = (int)L; { const int q = nwg / NXCD, r = nwg % NXCD, xcd = wgid % NXCD, off = wgid / NXCD; wgid = (xcd < r ? xcd * (q + 1) : r * (q + 1) + (xcd - r) * q) + off; }
        const int nig = wgm * nN, gid = wgid / nig, fm = gid * wgm, gsz = (nM - fm) < wgm ? (nM - fm) : wgm;
        u.pm = fm + ((wgid % nig) % gsz); u.pn = (wgid % nig) / gsz; return true;
    }
    __device__ __forceinline__ void a_ready(const Unit&) const {}
    __device__ __forceinline__ void done(const Unit&) const {}
};
__device__ __forceinline__ unsigned cvt_pk_bf16(float lo, float hi) { unsigned r; asm volatile("v_cvt_pk_bf16_f32 %0, %1, %2" : "=v"(r) : "v"(lo), "v"(hi)); return r; }
typedef float f32x2 __attribute__((ext_vector_type(2)));
template <class Epi, class Sched, bool ALIGN_EPI = false, bool SP2 = false>
__device__ __forceinline__ void gemm_phase(PG8_LAS unsigned char* lds, const Gemm g, const Sched& S, const Epi& E) {
    int tid_ = threadIdx.x; asm volatile("" : "+v"(tid_));
    const int tid = tid_, wid = __builtin_amdgcn_readfirstlane(tid >> 6), lane = tid & 63, wr = wid >> 2, wc = wid & 3, fr = lane & 15, fq = lane >> 4;
    const int K = g.K, nt = K / BK, lda = g.lda ? g.lda : K;
    unsigned voffA[2], voffB[2];
#pragma unroll
    for (int i = 0; i < 2; ++i) { int R, C; stage_rc(tid * 16 + i * 8192, R, C); const int Rb = Epi::PERM ? ((R & ~31) + perm32(R & 31)) : R;
        voffA[i] = (unsigned)(R * lda + C) * 2u; voffB[i] = (unsigned)(Rb * K + C) * 2u; }
    const size_t kstep = (size_t)(BK * 2);
    const size_t hstepA = (size_t)HALF * lda * 2, hstepB = (size_t)HALF * K * 2;
    const size_t tstepA = 2 * hstepA, tstepB = 2 * hstepB;
    const unsigned ldsw = (unsigned)wid * 1024u;
    const int aoff = lds_byte(wr * 64 + fr, fq * 8), boff = lds_byte(wc * 32 + fr, fq * 8);
#define PG8_SA(b, h) (((b) * 2 + (h)) * HTB)
#define PG8_SB(b, h) ((4 + (b) * 2 + (h)) * HTB)
#define PG8_STAGE(bufoff, gbase, voff) do { _Pragma("unroll") for (int _i = 0; _i < 2; ++_i) \
        __builtin_amdgcn_global_load_lds((const unsigned*)((const char*)(gbase) + (voff)[_i]), (PG8_LAS unsigned*)(lds + (bufoff) + ldsw + _i * 8192), 16, 0, 0); } while (0)
#define PG8_LDA(dst, b, h) do { _Pragma("unroll") for (int m = 0; m < 4; ++m) _Pragma("unroll") for (int k = 0; k < 2; ++k) dst[m][k] = *(const PG8_LAS bf16x8*)(lds + PG8_SA(b, h) + aoff + m * 2048 + k * 1024); } while (0)
#define PG8_LDB(dst, b, h) do { _Pragma("unroll") for (int n = 0; n < 2; ++n) _Pragma("unroll") for (int k = 0; k < 2; ++k) dst[n][k] = *(const PG8_LAS bf16x8*)(lds + PG8_SB(b, h) + boff + n * 2048 + k * 1024); } while (0)
#define PG8_MMA(ai, bj, At, Bt) do { __builtin_amdgcn_s_setprio(1); _Pragma("unroll") for (int m = 0; m < 4; ++m) _Pragma("unroll") for (int n = 0; n < 2; ++n) _Pragma("unroll") for (int k = 0; k < 2; ++k) \
        acc[ai][bj][m][n] = __builtin_amdgcn_mfma_f32_16x16x32_bf16(Bt[n][k], At[m][k], acc[ai][bj][m][n], 0, 0, 0); __builtin_amdgcn_s_setprio(0); } while (0)
#define PG8_WAIT_V(n) asm volatile("s_waitcnt vmcnt(" #n ")" ::: "memory")
#define PG8_WAIT_L(n) asm volatile("s_waitcnt lgkmcnt(" #n ")" ::: "memory")
#define PG8_BAR __builtin_amdgcn_s_barrier()
#define PG8_SCHED __builtin_amdgcn_sched_barrier(0)
    Unit cur, nxt; int ui = 0;
    if (!S.next(0, cur)) return;
    f32x4 acc[2][2][4][2];
#pragma unroll
    for (int a = 0; a < 2; ++a)
#pragma unroll
        for (int b = 0; b < 2; ++b)
#pragma unroll
            for (int m = 0; m < 4; ++m)
#pragma unroll
                for (int n = 0; n < 2; ++n) acc[a][b][m][n] = (f32x4){0.f, 0.f, 0.f, 0.f};
    bf16x8 At[4][2], B0[2][2], B1[2][2];
    const char* cA = (const char*)g.A + (size_t)cur.pm * tstepA; const char* cB = (const char*)g.Bt + (size_t)cur.pn * tstepB;
    S.a_ready(cur);
    if constexpr (SP2) {
        PG8_STAGE(PG8_SB(0, 0), cB, voffB); PG8_STAGE(PG8_SB(0, 1), cB + hstepB, voffB); PG8_STAGE(PG8_SA(0, 0), cA, voffA); PG8_STAGE(PG8_SA(0, 1), cA + hstepA, voffA);
        if (wr == 1) PG8_BAR;
        PG8_WAIT_V(2); PG8_BAR;
        PG8_STAGE(PG8_SB(1, 0), cB + kstep, voffB); PG8_STAGE(PG8_SA(1, 0), cA + kstep, voffA); PG8_STAGE(PG8_SB(1, 1), cB + hstepB + kstep, voffB);
        PG8_WAIT_V(6); PG8_BAR;
    } else {
        PG8_STAGE(PG8_SB(0, 0), cB, voffB); PG8_STAGE(PG8_SA(0, 0), cA, voffA); PG8_STAGE(PG8_SB(0, 1), cB + hstepB, voffB); PG8_STAGE(PG8_SA(0, 1), cA + hstepA, voffA);
        if (wr == 1) PG8_BAR;
        PG8_WAIT_V(4); PG8_BAR;
        PG8_STAGE(PG8_SB(1, 0), cB + kstep, voffB); PG8_STAGE(PG8_SA(1, 0), cA + kstep, voffA); PG8_STAGE(PG8_SB(1, 1), cB + hstepB + kstep, voffB);
        PG8_WAIT_V(6); PG8_BAR;
    }
    for (;;) {
        const bool has_next = S.next(ui + 1, nxt);
        const char* nA = has_next ? (const char*)g.A + (size_t)nxt.pm * tstepA : cA; const char* nB = has_next ? (const char*)g.Bt + (size_t)nxt.pn * tstepB : cB;
        for (int t = 0; t < nt; t += 2) {
            const bool last = (t == nt - 2);
            const char* a1 = cA + (size_t)(t + 1) * kstep;
            const char* a2 = last ? nA : cA + (size_t)(t + 2) * kstep; const char* b2 = last ? nB : cB + (size_t)(t + 2) * kstep;
            const char* a3 = a2 + kstep; const char* b3 = b2 + kstep;
            if (last && has_next) S.a_ready(nxt);
            if constexpr (SP2) {
            PG8_LDB(B0, 0, 0); PG8_LDB(B1, 0, 1); PG8_SCHED; PG8_LDA(At, 0, 0); PG8_STAGE(PG8_SA(1, 1), a1 + hstepA, voffA);
            PG8_WAIT_V(8); PG8_WAIT_L(0); PG8_BAR; PG8_MMA(0, 0, At, B0); PG8_MMA(0, 1, At, B1); PG8_BAR; PG8_SCHED;
            PG8_LDA(At, 0, 1); PG8_STAGE(PG8_SB(0, 0), b2, voffB); PG8_STAGE(PG8_SB(0, 1), b2 + hstepB, voffB); PG8_STAGE(PG8_SA(0, 0), a2, voffA);
            PG8_WAIT_V(8); PG8_WAIT_L(0); PG8_BAR; PG8_MMA(1, 0, At, B0); PG8_MMA(1, 1, At, B1); PG8_BAR; PG8_SCHED;
            PG8_LDB(B0, 1, 0); PG8_LDB(B1, 1, 1); PG8_SCHED; PG8_LDA(At, 1, 0); PG8_STAGE(PG8_SA(0, 1), a2 + hstepA, voffA);
            PG8_WAIT_V(8); PG8_WAIT_L(0); PG8_BAR; PG8_MMA(0, 0, At, B0); PG8_MMA(0, 1, At, B1); PG8_BAR; PG8_SCHED;
            PG8_LDA(At, 1, 1); PG8_STAGE(PG8_SB(1, 0), b3, voffB); PG8_STAGE(PG8_SB(1, 1), b3 + hstepB, voffB); PG8_STAGE(PG8_SA(1, 0), a3, voffA);
            PG8_WAIT_V(8); PG8_WAIT_L(0); PG8_BAR; PG8_MMA(1, 0, At, B0); PG8_MMA(1, 1, At, B1); PG8_BAR; PG8_SCHED;
            } else {
            PG8_LDB(B0, 0, 0); PG8_SCHED; PG8_LDA(At, 0, 0); PG8_STAGE(PG8_SA(1, 1), a1 + hstepA, voffA);
            PG8_WAIT_L(8); PG8_BAR; PG8_WAIT_L(0); PG8_MMA(0, 0, At, B0); PG8_BAR; PG8_SCHED;
            PG8_LDB(B1, 0, 1); PG8_STAGE(PG8_SB(0, 0), b2, voffB);
            PG8_BAR; PG8_WAIT_L(0); PG8_MMA(0, 1, At, B1); PG8_BAR;
            PG8_LDA(At, 0, 1); PG8_STAGE(PG8_SA(0, 0), a2, voffA);
            PG8_BAR; PG8_WAIT_L(0); PG8_MMA(1, 0, At, B0); PG8_BAR; PG8_SCHED;
            PG8_STAGE(PG8_SB(0, 1), b2 + hstepB, voffB);
            PG8_WAIT_V(6); PG8_BAR; PG8_MMA(1, 1, At, B1); PG8_BAR;
            PG8_LDB(B0, 1, 0); PG8_SCHED; PG8_LDA(At, 1, 0); PG8_STAGE(PG8_SA(0, 1), a2 + hstepA, voffA);
            PG8_WAIT_L(8); PG8_BAR; PG8_WAIT_L(0); PG8_MMA(0, 0, At, B0); PG8_BAR; PG8_SCHED;
            PG8_LDB(B1, 1, 1); PG8_STAGE(PG8_SB(1, 0), b3, voffB);
            PG8_BAR; PG8_WAIT_L(0); PG8_MMA(0, 1, At, B1); PG8_BAR;
            PG8_LDA(At, 1, 1); PG8_STAGE(PG8_SA(1, 0), a3, voffA);
            PG8_BAR; PG8_WAIT_L(0); PG8_MMA(1, 0, At, B0); PG8_BAR; PG8_SCHED;
            PG8_STAGE(PG8_SB(1, 1), b3 + hstepB, voffB);
            PG8_WAIT_V(6); PG8_BAR; PG8_MMA(1, 1, At, B1); PG8_BAR;
            }
        }
        if constexpr (ALIGN_EPI) { if (wr == 0) PG8_BAR; }
        if constexpr (!Epi::AFTER_DRAIN) { E(acc, cur, wr, wc, fr, fq); S.done(cur); }
        if (!has_next) break;
#pragma unroll
        for (int a = 0; a < 2; ++a)
#pragma unroll
            for (int b = 0; b < 2; ++b)
#pragma unroll
                for (int m = 0; m < 4; ++m)
#pragma unroll
                    for (int n = 0; n < 2; ++n) acc[a][b][m][n] = (f32x4){0.f, 0.f, 0.f, 0.f};
        cur = nxt; cA = nA; cB = nB; ++ui;
        if constexpr (ALIGN_EPI) { if (wr == 1) PG8_BAR; }
    }
    PG8_WAIT_V(0);
    if constexpr (!ALIGN_EPI) { if (wr == 0) PG8_BAR; }
    PG8_BAR;
    if constexpr (Epi::AFTER_DRAIN) { E.fused(acc, cur, wr, wc, fr, fq, lds, wid, lane); S.done(cur); }
}
template <class Epi, class Sched, bool ALIGN_EPI = false, bool SP2 = false>
__device__ __forceinline__ void gemm_phase2(PG8_LAS unsigned char* lds, const Gemm g, const bf16_t* A1, const bf16_t* Bt1, int K1, const Sched& S, const Epi& E) {
    int tid_ = threadIdx.x; asm volatile("" : "+v"(tid_));
    const int tid = tid_, wid = __builtin_amdgcn_readfirstlane(tid >> 6), lane = tid & 63, wr = wid >> 2, wc = wid & 3, fr = lane & 15, fq = lane >> 4;
    const int K = g.K  , lda = g.lda ? g.lda : K  , nt0 = g.N_seg0K / BK, nt1 = K1 / BK;
    unsigned voffA[2], voffB[2];
#pragma unroll
    for (int i = 0; i < 2; ++i) { int R, C; stage_rc(tid * 16 + i * 8192, R, C); const int Rb = Epi::PERM ? ((R & ~31) + perm32(R & 31)) : R;
        voffA[i] = (unsigned)(R * lda + C) * 2u; voffB[i] = (unsigned)(Rb * K + C) * 2u; }
    const size_t kstep = (size_t)(BK * 2);
    const size_t hstepA = (size_t)HALF * lda * 2, hstepB = (size_t)HALF * K * 2;
    const size_t tstepA = 2 * hstepA, tstepB = 2 * hstepB;
    const unsigned ldsw = (unsigned)wid * 1024u;
    const int aoff = lds_byte(wr * 64 + fr, fq * 8), boff = lds_byte(wc * 32 + fr, fq * 8);
#define PG8_SA(b, h) (((b) * 2 + (h)) * HTB)
#define PG8_SB(b, h) ((4 + (b) * 2 + (h)) * HTB)
#define PG8_STAGE(bufoff, gbase, voff) do { _Pragma("unroll") for (int _i = 0; _i < 2; ++_i) \
        __builtin_amdgcn_global_load_lds((const unsigned*)((const char*)(gbase) + (voff)[_i]), (PG8_LAS unsigned*)(lds + (bufoff) + ldsw + _i * 8192), 16, 0, 0); } while (0)
#define PG8_LDA(dst, b, h) do { _Pragma("unroll") for (int m = 0; m < 4; ++m) _Pragma("unroll") for (int k = 0; k < 2; ++k) dst[m][k] = *(const PG8_LAS bf16x8*)(lds + PG8_SA(b, h) + aoff + m * 2048 + k * 1024); } while (0)
#define PG8_LDB(dst, b, h) do { _Pragma("unroll") for (int n = 0; n < 2; ++n) _Pragma("unroll") for (int k = 0; k < 2; ++k) dst[n][k] = *(const PG8_LAS bf16x8*)(lds + PG8_SB(b, h) + boff + n * 2048 + k * 1024); } while (0)
#define PG8_MMA(ai, bj, At, Bt) do { __builtin_amdgcn_s_setprio(1); _Pragma("unroll") for (int m = 0; m < 4; ++m) _Pragma("unroll") for (int n = 0; n < 2; ++n) _Pragma("unroll") for (int k = 0; k < 2; ++k) \
        acc[ai][bj][m][n] = __builtin_amdgcn_mfma_f32_16x16x32_bf16(Bt[n][k], At[m][k], acc[ai][bj][m][n], 0, 0, 0); __builtin_amdgcn_s_setprio(0); } while (0)
#define PG8_WAIT_V(n) asm volatile("s_waitcnt vmcnt(" #n ")" ::: "memory")
#define PG8_WAIT_L(n) asm volatile("s_waitcnt lgkmcnt(" #n ")" ::: "memory")
#define PG8_BAR __builtin_amdgcn_s_barrier()
#define PG8_SCHED __builtin_amdgcn_sched_barrier(0)
    Unit cur, nxt; int ui = 0; int cseg = 0;
    if (!S.next(0, cur)) return;
    f32x4 acc[2][2][4][2];
#pragma unroll
    for (int a = 0; a < 2; ++a)
#pragma unroll
        for (int b = 0; b < 2; ++b)
#pragma unroll
            for (int m = 0; m < 4; ++m)
#pragma unroll
                for (int n = 0; n < 2; ++n) acc[a][b][m][n] = (f32x4){0.f, 0.f, 0.f, 0.f};
    bf16x8 At[4][2], B0[2][2], B1[2][2];
    const char* cA = (const char*)g.A + (size_t)cur.pm * tstepA; const char* cB = (const char*)g.Bt + (size_t)cur.pn * tstepB;
    if constexpr (SP2) {
        PG8_STAGE(PG8_SB(0, 0), cB, voffB); PG8_STAGE(PG8_SB(0, 1), cB + hstepB, voffB); PG8_STAGE(PG8_SA(0, 0), cA, voffA); PG8_STAGE(PG8_SA(0, 1), cA + hstepA, voffA);
        if (wr == 1) PG8_BAR;
        PG8_WAIT_V(2); PG8_BAR;
        PG8_STAGE(PG8_SB(1, 0), cB + kstep, voffB); PG8_STAGE(PG8_SA(1, 0), cA + kstep, voffA); PG8_STAGE(PG8_SB(1, 1), cB + hstepB + kstep, voffB);
        PG8_WAIT_V(6); PG8_BAR;
    } else {
        PG8_STAGE(PG8_SB(0, 0), cB, voffB); PG8_STAGE(PG8_SA(0, 0), cA, voffA); PG8_STAGE(PG8_SB(0, 1), cB + hstepB, voffB); PG8_STAGE(PG8_SA(0, 1), cA + hstepA, voffA);
        if (wr == 1) PG8_BAR;
        PG8_WAIT_V(4); PG8_BAR;
        PG8_STAGE(PG8_SB(1, 0), cB + kstep, voffB); PG8_STAGE(PG8_SA(1, 0), cA + kstep, voffA); PG8_STAGE(PG8_SB(1, 1), cB + hstepB + kstep, voffB);
        PG8_WAIT_V(6); PG8_BAR;
    }
    for (;;) {
        const int nseg = cseg ^ 1; bool has_next; if (cseg == 0) { nxt = cur; has_next = true; } else has_next = S.next((ui >> 1) + 1, nxt);
        const int nt = cseg ? nt1 : nt0;
        const char* nA = has_next ? (const char*)(nseg ? A1 : g.A) + (size_t)nxt.pm * tstepA : cA; const char* nB = has_next ? (const char*)(nseg ? Bt1 : g.Bt) + (size_t)nxt.pn * tstepB : cB;
        for (int t = 0; t < nt; t += 2) {
            const bool last = (t == nt - 2);
            const char* a1 = cA + (size_t)(t + 1) * kstep;
            const char* a2 = last ? nA : cA + (size_t)(t + 2) * kstep; const char* b2 = last ? nB : cB + (size_t)(t + 2) * kstep;
            const char* a3 = a2 + kstep; const char* b3 = b2 + kstep;
            if constexpr (SP2) {
            PG8_LDB(B0, 0, 0); PG8_LDB(B1, 0, 1); PG8_SCHED; PG8_LDA(At, 0, 0); PG8_STAGE(PG8_SA(1, 1), a1 + hstepA, voffA);
            PG8_WAIT_V(8); PG8_WAIT_L(0); PG8_BAR; PG8_MMA(0, 0, At, B0); PG8_MMA(0, 1, At, B1); PG8_BAR; PG8_SCHED;
            PG8_LDA(At, 0, 1); PG8_STAGE(PG8_SB(0, 0), b2, voffB); PG8_STAGE(PG8_SB(0, 1), b2 + hstepB, voffB); PG8_STAGE(PG8_SA(0, 0), a2, voffA);
            PG8_WAIT_V(8); PG8_WAIT_L(0); PG8_BAR; PG8_MMA(1, 0, At, B0); PG8_MMA(1, 1, At, B1); PG8_BAR; PG8_SCHED;
            PG8_LDB(B0, 1, 0); PG8_LDB(B1, 1, 1); PG8_SCHED; PG8_LDA(At, 1, 0); PG8_STAGE(PG8_SA(0, 1), a2 + hstepA, voffA);
            PG8_WAIT_V(8); PG8_WAIT_L(0); PG8_BAR; PG8_MMA(0, 0, At, B0); PG8_MMA(0, 1, At, B1); PG8_BAR; PG8_SCHED;
            PG8_LDA(At, 1, 1); PG8_STAGE(PG8_SB(1, 0), b3, voffB); PG8_STAGE(PG8_SB(1, 1), b3 + hstepB, voffB); PG8_STAGE(PG8_SA(1, 0), a3, voffA);
            PG8_WAIT_V(8); PG8_WAIT_L(0); PG8_BAR; PG8_MMA(1, 0, At, B0); PG8_MMA(1, 1, At, B1); PG8_BAR; PG8_SCHED;
            } else {
            PG8_LDB(B0, 0, 0); PG8_SCHED; PG8_LDA(At, 0, 0); PG8_STAGE(PG8_SA(1, 1), a1 + hstepA, voffA);
            PG8_WAIT_L(8); PG8_BAR; PG8_WAIT_L(0); PG8_MMA(0, 0, At, B0); PG8_BAR; PG8_SCHED;
            PG8_LDB(B1, 0, 1); PG8_STAGE(PG8_SB(0, 0), b2, voffB);
            PG8_BAR; PG8_WAIT_L(0); PG8_MMA(0, 1, At, B1); PG8_BAR;
            PG8_LDA(At, 0, 1); PG8_STAGE(PG8_SA(0, 0), a2, voffA);
            PG8_BAR; PG8_WAIT_L(0); PG8_MMA(1, 0, At, B0); PG8_BAR; PG8_SCHED;
            PG8_STAGE(PG8_SB(0, 1), b2 + hstepB, voffB);
            PG8_WAIT_V(6); PG8_BAR; PG8_MMA(1, 1, At, B1); PG8_BAR;
            PG8_LDB(B0, 1, 0); PG8_SCHED; PG8_LDA(At, 1, 0); PG8_STAGE(PG8_SA(0, 1), a2 + hstepA, voffA);
            PG8_WAIT_L(8); PG8_BAR; PG8_WAIT_L(0); PG8_MMA(0, 0, At, B0); PG8_BAR; PG8_SCHED;
            PG8_LDB(B1, 1, 1); PG8_STAGE(PG8_SB(1, 0), b3, voffB);
            PG8_BAR; PG8_WAIT_L(0); PG8_MMA(0, 1, At, B1); PG8_BAR;
            PG8_LDA(At, 1, 1); PG8_STAGE(PG8_SA(1, 0), a3, voffA);
            PG8_BAR; PG8_WAIT_L(0); PG8_MMA(1, 0, At, B0); PG8_BAR; PG8_SCHED;
            PG8_STAGE(PG8_SB(1, 1), b3 + hstepB, voffB);
            PG8_WAIT_V(6); PG8_BAR; PG8_MMA(1, 1, At, B1); PG8_BAR;
            }
        }
        if constexpr (ALIGN_EPI) { if (wr == 0) PG8_BAR; }
        if (cseg == 0) E.mid(acc, cur, wr, wc, fr, fq); else E(acc, cur, wr, wc, fr, fq);
        if (!has_next) break;
        if (cseg == 1) {
#pragma unroll
        for (int a = 0; a < 2; ++a)
#pragma unroll
            for (int b = 0; b < 2; ++b)
#pragma unroll
                for (int m = 0; m < 4; ++m)
#pragma unroll
                    for (int n = 0; n < 2; ++n) acc[a][b][m][n] = (f32x4){0.f, 0.f, 0.f, 0.f};
        }
        cur = nxt; cA = nA; cB = nB; ++ui; cseg = nseg;
        if constexpr (ALIGN_EPI) { if (wr == 1) PG8_BAR; }
    }
    PG8_WAIT_V(0);
    if constexpr (!ALIGN_EPI) { if (wr == 0) PG8_BAR; }
    PG8_BAR;
#undef PG8_SA
#undef PG8_SB
#undef PG8_STAGE
#undef PG8_LDA
#undef PG8_LDB
#undef PG8_MMA
#undef PG8_WAIT_V
#undef PG8_WAIT_L
#undef PG8_BAR
#undef PG8_SCHED
}
}
#ifndef PHM
#define PHM 255
#endif
#ifndef PROBE_DUP
#define PROBE_DUP 0
#endif
#ifndef P1_WGM
#define P1_WGM 8
#endif
namespace mk {
__device__ __forceinline__ int fresh_tid() { int t = threadIdx.x; asm volatile("" : "+v"(t)); return t; }
using pg8::bf16_t; using pg8::f32x4; using pg8::u32x4; using pg8::Unit;
#define LAS __attribute__((address_space(3)))
typedef short bf16x8 __attribute__((ext_vector_type(8)));
typedef float f32x16 __attribute__((ext_vector_type(16)));
typedef short s16x4 __attribute__((ext_vector_type(4)));
typedef short v4i16_t __attribute__((ext_vector_type(4)));

constexpr int NB = 8, S_ = 4096, D_ = 1024, M_ = NB * S_, IN_ = 3584, NGATE = 2048, NCAT = IN_ + NGATE, FF = 4096, POOL = 512, DEPTH = 2;
constexpr float EPS = 1e-6f, LOG2E = 1.4426950408889634f;
constexpr size_t MiB = 1u << 20;
constexpr int QLD = 1152, GLD = 2176, ULD = 640;
constexpr size_t WS_RS = 1 * MiB;
constexpr size_t WS_W = 3 * MiB;
constexpr size_t WO_CAT = 0, WO_COMB = (size_t)NCAT * 1024, WO_BA = WO_COMB + 1024 * 512, WO_OUT = WO_BA + 1024 * 1024, WO_UP = WO_OUT + 1024 * 1024, WO_DOWN = WO_UP + 4096 * 1024;
constexpr size_t WS_XBF = 35 * MiB;
constexpr size_t WS_U = 107 * MiB;
constexpr size_t WS_Q = 147 * MiB;
constexpr size_t WS_K = 219 * MiB;
constexpr size_t WS_V = 291 * MiB;
constexpr size_t WS_G = 363 * MiB;
constexpr size_t WS_YP = 499 * MiB;
constexpr size_t WS_MRG = WS_K;
constexpr size_t WS_H = WS_U;
constexpr size_t WS_COMB1 = 501 * MiB;
constexpr size_t WS_END = 503 * MiB;
constexpr size_t DO_YP = 0, DO_W0 = 80 * MiB;
constexpr int LDS_BYTES = 147456;
constexpr size_t NM_OFF = 512 * 1024;
constexpr int HLD = FF + 128;  static_assert(WS_H + (size_t)M_ * HLD * 2 <= WS_YP && WS_G + (size_t)M_ * GLD * 2 <= WS_YP, "ws map");

__device__ __forceinline__ unsigned pk2(float lo, float hi) { return pg8::cvt_pk_bf16(lo, hi); }
__device__ __forceinline__ float bflo(unsigned w) { return __uint_as_float(w << 16); }
__device__ __forceinline__ float bfhi(unsigned w) { return __uint_as_float(w & 0xffff0000u); }
__device__ __forceinline__ float wave_sum(float v) {
#pragma unroll
    for (int o = 1; o < 64; o <<= 1) v += __shfl_xor(v, o);
    return v;
}
__device__ __forceinline__ float wave_max(float v) {
#pragma unroll
    for (int o = 1; o < 64; o <<= 1) v = fmaxf(v, __shfl_xor(v, o));
    return v;
}
__device__ __forceinline__ float rstd_row(const float* RS, int row, int fq) {
    const f32x4 v = *(const f32x4*)(RS + (size_t)row * 16 + 4 * fq);
    float s = (v[0] + v[1]) + (v[2] + v[3]);
    s += __shfl_xor(s, 16); s += __shfl_xor(s, 32);
    return rsqrtf(s * (1.0f / 1024.0f) + EPS);
}
__device__ __forceinline__ float sigmoidf_(float z) { return __builtin_amdgcn_rcpf(1.0f + __builtin_amdgcn_exp2f(-z * LOG2E)); }

struct EpiIn {
    static constexpr bool PERM = true, AFTER_DRAIN = false;
    bf16_t *U, *Q, *K, *V, *G; const float* RS; const float* gq; const float* gk; const float* bgate; mutable float nq2, nk2;
    __device__ __forceinline__ void operator()(const f32x4 (&acc)[2][2][4][2], const Unit& u, int wr, int wc, int fr, int fq) const {
        const int row0 = u.pm * 256 + wr * 64 + fr, pn = u.pn;
        if (pn >= 2 && pn < 10) {
            const bool isq = pn < 6; bf16_t* base = isq ? Q : K; const int colt = (pn - (isq ? 2 : 6)) * 256 + 64 * wc + 8 * fq;
            const float* g = isq ? gq : gk; const float sc = isq ? 0.125f * LOG2E : 1.0f;
            f32x4 gv[2][2];
#pragma unroll
            for (int bj = 0; bj < 2; ++bj)
#pragma unroll
                for (int n = 0; n < 2; ++n) gv[bj][n] = *(const f32x4*)(g + 32 * bj + 8 * fq + 4 * n) * sc;
            float nmx = 0.f;
#pragma unroll
            for (int ai = 0; ai < 2; ++ai)
#pragma unroll
                for (int m = 0; m < 4; ++m) {
                    const int row = row0 + ai * 128 + m * 16; const float r = rstd_row(RS, row, fq);
                    f32x4 v[2][2]; float ss = 0.f;
#pragma unroll
                    for (int bj = 0; bj < 2; ++bj)
#pragma unroll
                        for (int n = 0; n < 2; ++n) { v[bj][n] = acc[ai][bj][m][n] * r; const f32x4 q = v[bj][n] * v[bj][n]; ss += (q[0] + q[1]) + (q[2] + q[3]); }
                    ss += __shfl_xor(ss, 16); ss += __shfl_xor(ss, 32);
                    const float rn = rsqrtf(ss * (1.0f / 64.0f) + EPS);
                    bf16_t* rowp = base + (size_t)row * QLD + colt; float n2 = 0.f;
#pragma unroll
                    for (int bj = 0; bj < 2; ++bj) { const f32x4 v0 = v[bj][0] * rn * gv[bj][0], v1 = v[bj][1] * rn * gv[bj][1];
                        const f32x4 q0 = v0 * v0, q1 = v1 * v1; n2 += ((q0[0] + q0[1]) + (q0[2] + q0[3])) + ((q1[0] + q1[1]) + (q1[2] + q1[3]));
                        u32x4 w; w.x = pk2(v0[0], v0[1]); w.y = pk2(v0[2], v0[3]); w.z = pk2(v1[0], v1[1]); w.w = pk2(v1[2], v1[3]);
                        __builtin_nontemporal_store(w, (u32x4*)(rowp + 32 * bj)); }
                    n2 += __shfl_xor(n2, 16); n2 += __shfl_xor(n2, 32);
                    nmx = fmaxf(nmx, n2);
                }
            if (isq) nq2 = fmaxf(nq2, nmx); else nk2 = fmaxf(nk2, nmx);
        } else {
            bf16_t* base; int ld, colt; bool sg = false;
            if (pn < 2) { base = U; ld = ULD; colt = pn * 256; } else if (pn < 14) { base = V; ld = QLD; colt = (pn - 10) * 256; } else { base = G; ld = GLD; colt = (pn - 14) * 256; sg = true; }
            const int col0 = colt + wc * 32 + 8 * fq;
            f32x4 bv[2][2];
#pragma unroll
            for (int bj = 0; bj < 2; ++bj)
#pragma unroll
                for (int n = 0; n < 2; ++n) bv[bj][n] = sg ? *(const f32x4*)(bgate + col0 + bj * 128 + 4 * n) : (f32x4){0.f, 0.f, 0.f, 0.f};
#pragma unroll
            for (int ai = 0; ai < 2; ++ai)
#pragma unroll
                for (int m = 0; m < 4; ++m) {
                    const int row = row0 + ai * 128 + m * 16; const float r = rstd_row(RS, row, fq);
                    bf16_t* rowp = base + (size_t)row * ld + col0;
#pragma unroll
                    for (int bj = 0; bj < 2; ++bj) { f32x4 v0 = acc[ai][bj][m][0] * r + bv[bj][0], v1 = acc[ai][bj][m][1] * r + bv[bj][1];
                        if (sg) {
#pragma unroll
                            for (int i = 0; i < 4; ++i) { v0[i] = sigmoidf_(v0[i]); v1[i] = sigmoidf_(v1[i]); } }
                        u32x4 w; w.x = pk2(v0[0], v0[1]); w.y = pk2(v0[2], v0[3]); w.z = pk2(v1[0], v1[1]); w.w = pk2(v1[2], v1[3]);
                        __builtin_nontemporal_store(w, (u32x4*)(rowp + bj * 128)); }
                }
        }
    }
};
struct EpiMerge2 {
    static constexpr bool PERM = true, AFTER_DRAIN = false;
    const bf16_t* G; bf16_t* MRG;
    __device__ __forceinline__ void mid(f32x4 (&acc)[2][2][4][2], const Unit& u, int wr, int wc, int fr, int fq) const {
        const int row0 = u.pm * 256 + wr * 64 + fr, col0 = u.pn * 256 + wc * 32 + 8 * fq;
#pragma unroll
        for (int ai = 0; ai < 2; ++ai)
#pragma unroll
            for (int m = 0; m < 4; ++m) {
                const int row = row0 + ai * 128 + m * 16;
#pragma unroll
                for (int bj = 0; bj < 2; ++bj) {
                    const bf16_t* gp = G + (size_t)row * GLD + col0 + bj * 128;
                    const u32x4 g0 = *(const u32x4*)gp, g1 = *(const u32x4*)(gp + 1024);
#define MK_RT(a, b) ((a) * __builtin_amdgcn_rcpf(fmaxf((b), 1e-30f)))
                    f32x4& v0 = acc[ai][bj][m][0]; f32x4& v1 = acc[ai][bj][m][1];
                    v0[0] *= MK_RT(bflo(g0.x), bflo(g1.x)); v0[1] *= MK_RT(bfhi(g0.x), bfhi(g1.x)); v0[2] *= MK_RT(bflo(g0.y), bflo(g1.y)); v0[3] *= MK_RT(bfhi(g0.y), bfhi(g1.y));
                    v1[0] *= MK_RT(bflo(g0.z), bflo(g1.z)); v1[1] *= MK_RT(bfhi(g0.z), bfhi(g1.z)); v1[2] *= MK_RT(bflo(g0.w), bflo(g1.w)); v1[3] *= MK_RT(bfhi(g0.w), bfhi(g1.w));
#undef MK_RT
                }
            }
    }
    __device__ __forceinline__ void operator()(const f32x4 (&acc)[2][2][4][2], const Unit& u, int wr, int wc, int fr, int fq) const {
        const int row0 = u.pm * 256 + wr * 64 + fr, col0 = u.pn * 256 + wc * 32 + 8 * fq;
#pragma unroll
        for (int ai = 0; ai < 2; ++ai)
#pragma unroll
            for (int m = 0; m < 4; ++m) {
                const int row = row0 + ai * 128 + m * 16;
#pragma unroll
                for (int bj = 0; bj < 2; ++bj) {
                    const u32x4 gw = *(const u32x4*)(G + (size_t)row * GLD + 1024 + col0 + bj * 128);
                    f32x4 v0 = acc[ai][bj][m][0], v1 = acc[ai][bj][m][1];
                    v0[0] *= bflo(gw.x); v0[1] *= bfhi(gw.x); v0[2] *= bflo(gw.y); v0[3] *= bfhi(gw.y);
                    v1[0] *= bflo(gw.z); v1[1] *= bfhi(gw.z); v1[2] *= bflo(gw.w); v1[3] *= bfhi(gw.w);
                    u32x4 w; w.x = pk2(v0[0], v0[1]); w.y = pk2(v0[2], v0[3]); w.z = pk2(v1[0], v1[1]); w.w = pk2(v1[2], v1[3]);
                    *(u32x4*)(MRG + (size_t)row * QLD + col0 + bj * 128) = w; }
            }
    }
};
struct EpiResid {
    static constexpr bool PERM = true, AFTER_DRAIN = false;
    float* out; bf16_t* xbf; float* RS; int wr_aux;
    __device__ __forceinline__ void operator()(const f32x4 (&acc)[2][2][4][2], const Unit& u, int wr, int wc, int fr, int fq) const {
        const int row0 = u.pm * 256 + wr * 64 + fr, col0 = u.pn * 256 + wc * 32 + 8 * fq;
#pragma unroll
        for (int ai = 0; ai < 2; ++ai)
#pragma unroll
            for (int m = 0; m < 4; ++m) {
                const int row = row0 + ai * 128 + m * 16; float ss = 0.f;
#pragma unroll
                for (int bj = 0; bj < 2; ++bj) {
                    const size_t off = (size_t)row * 1024 + col0 + bj * 128, xoff = (size_t)row * QLD + col0 + bj * 128;
                    const u32x4 xw = *(const u32x4*)(xbf + xoff);
                    f32x4 v0 = acc[ai][bj][m][0], v1 = acc[ai][bj][m][1];
                    v0[0] += bflo(xw.x); v0[1] += bfhi(xw.x); v0[2] += bflo(xw.y); v0[3] += bfhi(xw.y);
                    v1[0] += bflo(xw.z); v1[1] += bfhi(xw.z); v1[2] += bflo(xw.w); v1[3] += bfhi(xw.w);
                    if (wr_aux) {
                        const f32x4 q0 = v0 * v0, q1 = v1 * v1; ss += ((q0[0] + q0[1]) + (q0[2] + q0[3])) + ((q1[0] + q1[1]) + (q1[2] + q1[3]));
                        u32x4 w; w.x = pk2(v0[0], v0[1]); w.y = pk2(v0[2], v0[3]); w.z = pk2(v1[0], v1[1]); w.w = pk2(v1[2], v1[3]);
                        *(u32x4*)(xbf + xoff) = w;
                    } else { *(f32x4*)(out + off) = v0; *(f32x4*)(out + off + 4) = v1; }
                }
                if (wr_aux) { ss += __shfl_xor(ss, 16); ss += __shfl_xor(ss, 32); if (fq == 0) RS[(size_t)row * 16 + u.pn * 4 + wc] = ss; }
            }
    }
};
struct EpiNull {
    static constexpr bool PERM = true, AFTER_DRAIN = false;
    __device__ __forceinline__ void operator()(const f32x4 (&acc)[2][2][4][2], const Unit& u, int wr, int wc, int fr, int fq) const {
#pragma unroll
        for (int ai = 0; ai < 2; ++ai)
#pragma unroll
            for (int bj = 0; bj < 2; ++bj)
#pragma unroll
                for (int m = 0; m < 4; ++m) asm volatile("" :: "v"(acc[ai][bj][m][0]), "v"(acc[ai][bj][m][1]));
    }
};
template <int NORS> struct EpiUpT {
    static constexpr bool PERM = true, AFTER_DRAIN = false;
    bf16_t* H; const float* RS;
    __device__ __forceinline__ void operator()(const f32x4 (&acc)[2][2][4][2], const Unit& u, int wr, int wc, int fr, int fq) const {
        const int row0 = u.pm * 256 + wr * 64 + fr, col0 = u.pn * 256 + wc * 32 + 8 * fq;
#pragma unroll
        for (int ai = 0; ai < 2; ++ai)
#pragma unroll
            for (int m = 0; m < 4; ++m) {
                const int row = row0 + ai * 128 + m * 16; const float r = NORS ? 1.0f : rstd_row(RS, row, fq);
#pragma unroll
                for (int bj = 0; bj < 2; ++bj) {
                    f32x4 v0 = acc[ai][bj][m][0] * r, v1 = acc[ai][bj][m][1] * r;
#pragma unroll
                    for (int i = 0; i < 4; ++i) { const float a = fmaxf(v0[i], 0.f), b = fmaxf(v1[i], 0.f); v0[i] = a * a; v1[i] = b * b; }
                    u32x4 w; w.x = pk2(v0[0], v0[1]); w.y = pk2(v0[2], v0[3]); w.z = pk2(v1[0], v1[1]); w.w = pk2(v1[2], v1[3]);
                    __builtin_nontemporal_store(w, (u32x4*)(H + (size_t)row * HLD + col0 + bj * 128)); }
            }
    }
};

typedef EpiUpT<0> EpiUp;
__device__ __forceinline__ int qk_perm_row(int n) {
    if (n < 512 || n >= 2560) return n;
    const int c = n - 512; return 512 + (c & ~255) + 128 * ((c >> 5) & 1) + 32 * ((c >> 6) & 3) + (c & 31);
}
__device__ __forceinline__ void transpose_item(const float* W, int K, int N, bf16_t* WT, int row_off, const float* gk, bool permqk, LAS float* scr, int item, int lane) {
    const int nblk = N / 64, kb = item / nblk, nb = item % nblk, k0 = 64 * kb, n0 = 64 * nb, kr = lane >> 4, nc = lane & 15;
    f32x4 v[16];
#pragma unroll
    for (int i = 0; i < 16; ++i) v[i] = *(const f32x4*)(W + (size_t)(k0 + 4 * i + kr) * N + n0 + 4 * nc);
    if (gk) {
#pragma unroll
        for (int i = 0; i < 16; ++i) v[i] = v[i] * gk[k0 + 4 * i + kr];
    }
#pragma unroll
    for (int i = 0; i < 16; ++i)
#pragma unroll
        for (int e = 0; e < 4; ++e) scr[(4 * nc + e) * 65 + 4 * i + kr] = v[i][e];
    asm volatile("s_waitcnt lgkmcnt(0)" ::: "memory");
    const int c = lane & 7;
#pragma unroll
    for (int j = 0; j < 8; ++j) { const int n = (lane >> 3) + 8 * j; const LAS float* s = scr + n * 65 + 8 * c;
        u32x4 o; o.x = pk2(s[0], s[1]); o.y = pk2(s[2], s[3]); o.z = pk2(s[4], s[5]); o.w = pk2(s[6], s[7]);
        const int dr = permqk ? qk_perm_row(n0 + n) : (n0 + n);
        *(u32x4*)(WT + (size_t)(row_off + dr) * K + k0 + 8 * c) = o; }
    asm volatile("s_waitcnt lgkmcnt(0)" ::: "memory");
}

struct Args { const float* in[17]; float* out; unsigned char* ws; };

__device__ __forceinline__ void p0_phase(const Args& a, int l, LAS unsigned char* lds, int vcu, int G) {
    const int tid = fresh_tid(), lane = tid & 63, wave = __builtin_amdgcn_readfirstlane(tid >> 6);
    LAS float* scr = (LAS float*)(lds + wave * 16640);
    const int gw = vcu * 8 + wave, NGW = G * 8;
    bf16_t* Wb = l ? (bf16_t*)(a.ws + WS_W) : (bf16_t*)((unsigned char*)a.out + DO_W0);
    if (blockIdx.x == 0 && tid < 16) ((unsigned*)a.ws)[64 * tid] = 0u;
    const float* g_mix = a.in[1] + (size_t)l * 1024; const float* w_in = a.in[2] + (size_t)l * 1024 * IN_;
    const float* w_grp = a.in[3] + (size_t)l * 4 * 128 * 128; const float* pscale = a.in[4] + (size_t)l * 512;
    const float* w_bp = a.in[9] + (size_t)l * 512 * 1024; const float* w_ba = a.in[10] + (size_t)l * 1024 * 1024;
    const float* w_gate = a.in[11] + (size_t)l * 1024 * NGATE; const float* w_out = a.in[13] + (size_t)l * 1024 * 1024;
    const float* g_ffn = a.in[14] + (size_t)l * 1024; const float* w_up = a.in[15] + (size_t)l * 1024 * FF; const float* w_down = a.in[16] + (size_t)l * FF * 1024;
    constexpr int I_IN = 16 * (IN_ / 64), I_GATE = 16 * (NGATE / 64), I_BA = 16 * 16, I_OUT = 16 * 16, I_UP = 16 * (FF / 64), I_DOWN = 64 * 16;
    constexpr int NITEMS = I_IN + I_GATE + I_BA + I_OUT + I_UP + I_DOWN;
    for (int it = gw; it < NITEMS; it += NGW) {
        int r = it;
        if (r < I_IN) { transpose_item(w_in, 1024, IN_, Wb + WO_CAT, 0, g_mix, true, scr, r, lane); continue; } r -= I_IN;
        if (r < I_GATE) { transpose_item(w_gate, 1024, NGATE, Wb + WO_CAT, IN_, g_mix, false, scr, r, lane); continue; } r -= I_GATE;
        if (r < I_BA) { transpose_item(w_ba, 1024, 1024, Wb + WO_BA, 0, nullptr, false, scr, r, lane); continue; } r -= I_BA;
        if (r < I_OUT) { transpose_item(w_out, 1024, 1024, Wb + WO_OUT, 0, nullptr, false, scr, r, lane); continue; } r -= I_OUT;
        if (r < I_UP) { transpose_item(w_up, 1024, FF, Wb + WO_UP, 0, g_ffn, false, scr, r, lane); continue; } r -= I_UP;
        transpose_item(w_down, FF, 1024, Wb + WO_DOWN, 0, nullptr, false, scr, r, lane);
    }
    __syncthreads();
    for (int it = vcu; it < 64; it += G) {
        const int g = it >> 4, cb = (it >> 1) & 7, n = (it & 1) * 512 + tid;
        LAS float* wl = (LAS float*)lds;
#pragma unroll
        for (int j = 0; j < 4; ++j) { const int e = tid + 512 * j, cc = e >> 7, d = e & 127; wl[e] = w_grp[((size_t)g * 128 + cb * 16 + cc) * 128 + d] * pscale[g * 128 + d]; }
        __syncthreads();
        const float* bp = w_bp + (size_t)(g * 128) * 1024 + n;
        float acc[16];
#pragma unroll
        for (int cc = 0; cc < 16; ++cc) acc[cc] = 0.f;
#pragma unroll 8
        for (int d = 0; d < 128; ++d) { const float bv = bp[(size_t)d * 1024];
#pragma unroll
            for (int cc = 0; cc < 16; ++cc) acc[cc] += wl[cc * 128 + d] * bv; }
        u32x4 o0, o1;
        o0.x = pk2(acc[0], acc[1]); o0.y = pk2(acc[2], acc[3]); o0.z = pk2(acc[4], acc[5]); o0.w = pk2(acc[6], acc[7]);
        o1.x = pk2(acc[8], acc[9]); o1.y = pk2(acc[10], acc[11]); o1.z = pk2(acc[12], acc[13]); o1.w = pk2(acc[14], acc[15]);
        bf16_t* op = (bf16_t*)(a.ws + (l ? WS_COMB1 : WS_YP)) + (size_t)n * 1024 + g * 128 + cb * 16;
        *(u32x4*)op = o0; *(u32x4*)(op + 8) = o1;
        __syncthreads();
    }
    if (l == 0) {
        const float* x = a.in[0]; bf16_t* xbf = (bf16_t*)(a.ws + WS_XBF); float* RS = (float*)(a.ws + WS_RS);
        for (int m = gw; m < M_; m += NGW) {
            const f32x4* xr = (const f32x4*)(x + (size_t)m * 1024) + lane; f32x4 v[4]; float s = 0.f;
#pragma unroll
            for (int j = 0; j < 4; ++j) { v[j] = xr[64 * j]; const f32x4 q = v[j] * v[j]; s += (q[0] + q[1]) + (q[2] + q[3]); }
            s = wave_sum(s);
            unsigned long long* o8 = (unsigned long long*)(xbf + (size_t)m * QLD) + lane;
#pragma unroll
            for (int j = 0; j < 4; ++j) o8[64 * j] = (unsigned long long)pk2(v[j][0], v[j][1]) | ((unsigned long long)pk2(v[j][2], v[j][3]) << 32);
            if (lane < 16) RS[(size_t)m * 16 + lane] = lane == 0 ? s : 0.f;
        }
    }
}

template <int W> __device__ __forceinline__ void mix_item(const bf16_t* U, bf16_t* YP, int blk, int g, int lane) {
    const int sub = lane >> 4, ch = lane & 15, row0 = blk * 32 + sub * 8, t0 = row0 & (S_ - 1);
    const bf16_t* p = U + (size_t)row0 * ULD + g * 128 + ch * 8;
    u32x4 v[W + 7];
#pragma unroll
    for (int i = 0; i < W + 7; ++i) { const int dt = i - (W - 1); v[i] = (t0 + dt >= 0) ? *(const u32x4*)(p + (ptrdiff_t)dt * ULD) : (u32x4){0u, 0u, 0u, 0u}; }
#pragma unroll
    for (int r = 0; r < 8; ++r) {
        float s0 = 0.f, s1 = 0.f, s2 = 0.f, s3 = 0.f, s4 = 0.f, s5 = 0.f, s6 = 0.f, s7 = 0.f;
#pragma unroll
        for (int j = 0; j < W; ++j) { const u32x4 x = v[r + W - 1 - j];
            s0 += bflo(x.x); s1 += bfhi(x.x); s2 += bflo(x.y); s3 += bfhi(x.y); s4 += bflo(x.z); s5 += bfhi(x.z); s6 += bflo(x.w); s7 += bfhi(x.w); }
        const int t = t0 + r; const float inv = 1.0f / (float)((t + 1 < W) ? (t + 1) : W); const u32x4 self = v[r + W - 1];
        u32x4 o; o.x = pk2(s0 * inv - bflo(self.x), s1 * inv - bfhi(self.x)); o.y = pk2(s2 * inv - bflo(self.y), s3 * inv - bfhi(self.y));
        o.z = pk2(s4 * inv - bflo(self.z), s5 * inv - bfhi(self.z)); o.w = pk2(s6 * inv - bflo(self.w), s7 * inv - bfhi(self.w));
        *(u32x4*)(YP + (size_t)(row0 + r) * QLD + g * 128 + ch * 8) = o;
    }
}
__device__ __forceinline__ void mix_phase(const bf16_t* U, bf16_t* YP, int vcu, int G) {
    const int tid = fresh_tid(), lane = tid & 63, wave = __builtin_amdgcn_readfirstlane(tid >> 6);
    for (int it = vcu * 8 + wave; it < (M_ / 32) * 4; it += G * 8) {
        const int g = it & 3, blk = it >> 2;
        if (g == 0) mix_item<2>(U, YP, blk, 0, lane); else if (g == 1) mix_item<4>(U, YP, blk, 1, lane); else if (g == 2) mix_item<8>(U, YP, blk, 2, lane); else mix_item<16>(U, YP, blk, 3, lane);
    }
}

__device__ __forceinline__ int crow(int r, int hi) { return (r & 3) + 8 * (r >> 2) + 4 * hi; }
__device__ __forceinline__ s16x4 vtr(const LAS unsigned char* p) { return __builtin_bit_cast(s16x4, __builtin_amdgcn_ds_read_tr16_b64_v4i16((LAS v4i16_t*)p)); }
constexpr int AT_STG = 32768, AT_VOF = 16384, AT_WSF = 3 * AT_STG;
static_assert(AT_WSF + 2048 <= 131072 && AT_WSF >= 65536, "attention LDS map");
__device__ __forceinline__ void glds16(const void* gsrc, unsigned lds_dst) { unsigned keep;
    asm volatile("s_mov_b32 %0, m0\n\ts_mov_b32 m0, %2\n\ts_nop 0\n\tglobal_load_lds_dwordx4 %1, off\n\ts_mov_b32 m0, %0" : "=&s"(keep) : "v"(gsrc), "s"(lds_dst) : "memory"); }
#define AT_WAIT_BAR(N) asm volatile("s_waitcnt vmcnt(" #N ") lgkmcnt(0)\n\ts_barrier" ::: "memory")

__device__ __forceinline__ void attn_unit(int b, int h, int qb, const bf16_t* Q, const bf16_t* K, const bf16_t* V, bf16_t* O, const float* gsub, float lam, float oscale, float M2, int kt_lo, LAS unsigned char* lds, int tid, bool do_store = true) {
    const int lane = tid & 63, r32 = lane & 31, hi = lane >> 5, wid = __builtin_amdgcn_readfirstlane(tid >> 6), rg = wid & 3, mp = wid >> 2;
    const size_t rowbase = (size_t)b * S_; const int q0 = qb * 128;
    const bf16_t* Qw = Q + (rowbase + q0 + 32 * rg + r32) * QLD + h * 128 + mp * 64 + hi * 8;
    bf16x8 qr[4];
#pragma unroll
    for (int d0 = 0; d0 < 4; ++d0) qr[d0] = *(const bf16x8*)(Qw + d0 * 16);
    const int NT = 2 * qb + 2, ktmax = 2 * qb + (rg >> 1);
    const float sl2 = __builtin_amdgcn_exp2f(-(float)(h + 1)) * LOG2E;
    const int drow = 8 * wid + (lane >> 4), dch = lane & 15;
    const bf16_t* ks0 = K + (rowbase + (size_t)kt_lo * 64 + drow) * QLD + h * 128 + ((dch ^ (drow & 15)) << 3);
    const bf16_t* ks1 = K + (rowbase + (size_t)kt_lo * 64 + drow + 4) * QLD + h * 128 + ((dch ^ ((drow + 4) & 15)) << 3);
    const bf16_t* vs0 = V + (rowbase + (size_t)kt_lo * 64 + drow) * QLD + h * 128 + ((dch ^ ((drow & 3) << 2)) << 3);
    const bf16_t* vs1 = vs0 + 4 * QLD;
    const unsigned ldsb = (unsigned)(size_t)lds + (unsigned)wid * 2048u;
#define AT_DMA(stage) do { const unsigned d_ = (unsigned)__builtin_amdgcn_readfirstlane((int)(ldsb + (unsigned)(stage) * AT_STG)); \
        glds16(ks0, d_); glds16(ks1, d_ + 1024u); glds16(vs0, d_ + AT_VOF); glds16(vs1, d_ + AT_VOF + 1024u); \
        ks0 += 64 * QLD; ks1 += 64 * QLD; vs0 += 64 * QLD; vs1 += 64 * QLD; } while (0)
    int st_c = 0;
    AT_DMA(0);
    if (kt_lo + 1 < NT) AT_DMA(1);
    asm volatile("" :: "v"(qr[0]), "v"(qr[1]), "v"(qr[2]), "v"(qr[3]));
    f32x16 o[4];
#pragma unroll
    for (int c = 0; c < 4; ++c)
#pragma unroll
        for (int r = 0; r < 16; ++r) o[c][r] = 0.f;
    float l = 0.f;
    int kofs[4], vofs[4];
    { const int q4 = (lane & 15) >> 2, p4 = lane & 3, blk = (lane >> 4) & 1;
#pragma unroll
      for (int d0 = 0; d0 < 4; ++d0) kofs[d0] = r32 * 256 + (((mp * 8 + 2 * d0 + hi) ^ (r32 & 15)) << 4);
#pragma unroll
      for (int c = 0; c < 4; ++c) vofs[c] = AT_VOF + (4 * hi + q4) * 256 + ((((c ^ q4) << 2) | (blk << 1) | (p4 >> 1)) << 4) + 8 * (p4 & 1); }
    const float qposf = (float)(q0 + 32 * rg + r32 - 4 * hi);
    for (int kt = kt_lo; kt < NT; ++kt) {
        if (kt + 1 < NT) AT_WAIT_BAR(4); else AT_WAIT_BAR(0);
        if (kt + 2 < NT) AT_DMA(st_c == 0 ? 2 : st_c - 1);
        if (kt <= ktmax) {
            const LAS unsigned char* sb = lds + st_c * AT_STG;
            f32x16 s0, s1;
#pragma unroll
            for (int r = 0; r < 16; ++r) { s0[r] = -M2; s1[r] = -M2; }
#pragma unroll
            for (int d0 = 0; d0 < 4; ++d0) {
                const bf16x8 a0 = *(const LAS bf16x8*)(sb + kofs[d0]), a1 = *(const LAS bf16x8*)(sb + kofs[d0] + 32 * 256);
                s0 = __builtin_amdgcn_mfma_f32_32x32x16_bf16(a0, qr[d0], s0, 0, 0, 0);
                s1 = __builtin_amdgcn_mfma_f32_32x32x16_bf16(a1, qr[d0], s1, 0, 0, 0);
            }
            s16x4 va[4][2], vc[4][2];
#define AT_VRD(dst, ks) do { _Pragma("unroll") for (int c = 0; c < 4; ++c) { dst[c][0] = vtr(sb + vofs[c] + (ks) * 16 * 256); dst[c][1] = vtr(sb + vofs[c] + (ks) * 16 * 256 + 8 * 256); } } while (0)
#define AT_VMM(src, ks) do { _Pragma("unroll") for (int c = 0; c < 4; ++c) { const bf16x8 vf = (bf16x8){src[c][0][0], src[c][0][1], src[c][0][2], src[c][0][3], src[c][1][0], src[c][1][1], src[c][1][2], src[c][1][3]}; \
                o[c] = __builtin_amdgcn_mfma_f32_32x32x16_bf16(__builtin_bit_cast(bf16x8, pw[ks]), vf, o[c], 0, 0, 0); } } while (0)
            AT_VRD(va, 0);
            __builtin_amdgcn_sched_barrier(0);
            const float dq = qposf - (float)(kt * 64);
            float ls = 0.f;
#pragma unroll
            for (int r = 0; r < 16; ++r) { const float d = dq - (float)((r & 3) + 8 * (r >> 2));
                s0[r] = __builtin_amdgcn_exp2f(__builtin_fmaf(-sl2, __builtin_fabsf(d), s0[r]));
                s1[r] = __builtin_amdgcn_exp2f(__builtin_fmaf(-sl2, __builtin_fabsf(d - 32.0f), s1[r]));
                ls += s0[r] + s1[r]; }
            l += ls;
            u32x4 pw[4];
#pragma unroll
            for (int j = 0; j < 4; ++j) { pw[0][j] = pk2(s0[2 * j], s0[2 * j + 1]); pw[1][j] = pk2(s0[8 + 2 * j], s0[8 + 2 * j + 1]); pw[2][j] = pk2(s1[2 * j], s1[2 * j + 1]); pw[3][j] = pk2(s1[8 + 2 * j], s1[8 + 2 * j + 1]); }
            __builtin_amdgcn_sched_barrier(0);
            AT_VRD(vc, 1); __builtin_amdgcn_sched_barrier(0);
            AT_VMM(va, 0); __builtin_amdgcn_sched_barrier(0);
            AT_VRD(va, 2); __builtin_amdgcn_sched_barrier(0);
            AT_VMM(vc, 1); __builtin_amdgcn_sched_barrier(0);
            AT_VRD(vc, 3); __builtin_amdgcn_sched_barrier(0);
            AT_VMM(va, 2); __builtin_amdgcn_sched_barrier(0);
            AT_VMM(vc, 3); __builtin_amdgcn_sched_barrier(0);
#undef AT_VRD
#undef AT_VMM
        }
        st_c = (st_c == 2) ? 0 : st_c + 1;
    }
    AT_WAIT_BAR(0);
#undef AT_DMA
    l += __shfl_xor(l, 32);
    LAS float* wsf = (LAS float*)(lds + AT_WSF) + wid * 64;
    if (hi == 0) wsf[r32] = l;
    asm volatile("s_waitcnt lgkmcnt(0)" ::: "memory");
#pragma unroll
    for (int r = 0; r < 16; ++r) { const float rl = 1.0f / wsf[crow(r, hi)];
#pragma unroll
        for (int c = 0; c < 4; ++c) o[c][r] *= rl; }
    LAS float* X = (LAS float*)lds + rg * 4096;
    if (mp == 1) {
#pragma unroll
        for (int c = 0; c < 4; ++c)
#pragma unroll
            for (int r = 0; r < 16; ++r) X[crow(r, hi) * 128 + 32 * c + r32] = o[c][r];
    }
    __syncthreads();
    if (mp == 0 && do_store) {
        float gs[4];
#pragma unroll
        for (int c = 0; c < 4; ++c) gs[c] = gsub[32 * c + r32] * oscale;
#pragma unroll
        for (int r = 0; r < 16; ++r) {
            float ss = 0.f;
#pragma unroll
            for (int c = 0; c < 4; ++c) { o[c][r] -= lam * X[crow(r, hi) * 128 + 32 * c + r32]; ss += o[c][r] * o[c][r]; }
            ss += __shfl_xor(ss, 1); ss += __shfl_xor(ss, 2); ss += __shfl_xor(ss, 4); ss += __shfl_xor(ss, 8); ss += __shfl_xor(ss, 16);
            const float rn = rsqrtf(ss * (1.0f / 128.0f) + EPS);
            bf16_t* op = O + (rowbase + q0 + 32 * rg + crow(r, hi)) * QLD + h * 128 + r32;
#pragma unroll
            for (int c = 0; c < 4; ++c) op[32 * c] = (bf16_t)(pk2(o[c][r] * rn * gs[c], 0.f) & 0xffffu);
        }
    }
    __syncthreads();
}

constexpr int AT_ORD = 131072;
constexpr float AT_THR2 = 40.0f;
__device__ __forceinline__ void attn_phase(const Args& a, int l, LAS unsigned char* lds, int bx, int pass = 0, bool do_store = true) {
    const int tid = fresh_tid(), lane = tid & 63;
    const float* gq = a.in[5] + l * 64; const float* gk = a.in[6] + l * 64; const float* lq = a.in[7] + l * 256; const float* gsub = a.in[8] + l * 128;
    const float lambda_init = 0.8f - 0.6f * expf(-0.3f * (float)l);
    const float lam = expf(wave_sum(lq[lane] * lq[64 + lane])) - expf(wave_sum(lq[128 + lane] * lq[192 + lane])) + lambda_init;
    float M2 = 8.0f * wave_max(fabsf(gq[lane])) * wave_max(fabsf(gk[lane])) * LOG2E;
    { const float* nm = (const float*)(a.ws + NM_OFF) + (size_t)l * 8192;
      float mv = 0.f; const int nent = (int)gridDim.x * 16;
      for (int e2 = tid; e2 < nent; e2 += 512) mv = fmaxf(mv, nm[e2]);
      const float wq = wave_max((tid & 1) ? 0.f : mv), wk = wave_max((tid & 1) ? mv : 0.f);
      LAS float* red = (LAS float*)(lds + AT_ORD + 3072);
      if (lane == 0) { red[2 * (tid >> 6)] = wq; red[2 * (tid >> 6) + 1] = wk; }
      __syncthreads();
      float mq = 0.f, mk = 0.f;
#pragma unroll
      for (int w = 0; w < 8; ++w) { mq = fmaxf(mq, red[2 * w]); mk = fmaxf(mk, red[2 * w + 1]); }
      M2 = fminf(M2, sqrtf(mq) * sqrtf(mk) * 1.01f); }
    const bf16_t* Q = (const bf16_t*)(a.ws + WS_Q); const bf16_t* K = (const bf16_t*)(a.ws + WS_K); const bf16_t* V = (const bf16_t*)(a.ws + WS_V);
    LAS int* ord = (LAS int*)(lds + AT_ORD); LAS int* cst = ord + 256; LAS int* cur = cst + 256;
    unsigned* ctr = (unsigned*)a.ws + 512 * pass;
    int my_lo = 0;
    if (tid < 256) {
        const int h = tid >> 5, qb = tid & 31;
        const float sl2 = __builtin_amdgcn_exp2f(-(float)(h + 1)) * LOG2E, Wd = (2.0f * M2 + AT_THR2) / sl2;
        const float x = ((float)(128 * qb - 63) - Wd) * (1.0f / 64.0f);
        my_lo = x > 0.f ? (int)ceilf(x) : 0;
        cst[tid] = ((2 * qb + 2 - my_lo) << 8) | my_lo;
    }
    if (tid < 256) ord[(7 - (tid >> 5)) * 32 + 31 - (tid & 31)] = tid;
    __syncthreads();
    const int xcc = (int)(__builtin_amdgcn_s_getreg((3 << 11) | 20) & 0xFu) & 7;
    for (int qi = 0; qi < 8; ++qi) {
        const int qx = (xcc + qi) & 7;
        for (;;) {
            if (tid == 0) cur[0] = (int)__hip_atomic_fetch_add(ctr + 64 * qx, 1u, __ATOMIC_RELAXED, __HIP_MEMORY_SCOPE_AGENT);
            __syncthreads();
            const int idx = cur[0];
            __syncthreads();
            if (idx >= 256) break;
            const int t = ord[idx], klo = cst[t] & 255;
            attn_unit(qx, t >> 5, t & 31, Q, K, V, (bf16_t*)(a.ws + WS_Q), gsub, lam, 1.0f - lambda_init, M2, klo, lds, tid, do_store);
        }
    }
}

#define XB_TMO      128
#define XB_XCNT(j)  (256  + 64 * (j))
#define XB_XSUB(j)  (1280 + 64 * (j))
#define XB_XGEN(j)  (2304 + 64 * (j))
#define XB_TOP      3328
#define XB_TOPGEN   3392
#define XCD_BAR_WORDS 3456
#define XB_SPIN_CAP (1u << 18)

__device__ __forceinline__ unsigned xb_ld(unsigned* p)              { return __hip_atomic_load(p, __ATOMIC_RELAXED, __HIP_MEMORY_SCOPE_AGENT); }
__device__ __forceinline__ unsigned xb_add(unsigned* p, unsigned v) { return __hip_atomic_fetch_add(p, v, __ATOMIC_RELAXED, __HIP_MEMORY_SCOPE_AGENT); }
__device__ __forceinline__ unsigned xb_xcc_id() { return (unsigned)__builtin_amdgcn_s_getreg((3 << 11) | 20) & 0xFu; }
#define XB_SPIN(cond, bar) do { unsigned _sp = 0; while (cond) { __builtin_amdgcn_s_sleep(1); \
    if ((++_sp & 255u) == 0u) { if (xb_ld(&(bar)[XB_TMO])) break; if (_sp > XB_SPIN_CAP) { atomicAdd(&(bar)[XB_TMO], 1u); break; } } } } while (0)

struct XcdBarrier {
    unsigned* bar; unsigned x;
    volatile __attribute__((address_space(3))) unsigned* st;
};

__device__ __forceinline__ XcdBarrier xcd_barrier_post(unsigned* bar, volatile __attribute__((address_space(3))) unsigned* st) {
    XcdBarrier b; b.bar = bar; b.x = xb_xcc_id(); b.st = st;
    if (threadIdx.x == 0) (void)xb_add(&bar[XB_XCNT(b.x)], 1u);
    return b;
}
__device__ __forceinline__ void xcd_barrier_complete(unsigned* bar, unsigned x, unsigned& nloc, unsigned& nx) {
    const unsigned G = gridDim.x * gridDim.y * gridDim.z;
    unsigned sum, cnt, mine, sp = 0u;
    for (;;) {
        sum = 0u; cnt = 0u; mine = 0u;
#pragma unroll
        for (unsigned j = 0; j < 16; ++j) { const unsigned c = xb_ld(&bar[XB_XCNT(j)]); sum += c; cnt += (c > 0u) ? 1u : 0u; mine = (j == x) ? c : mine; }
        if (sum == G) break;
        __builtin_amdgcn_s_sleep(1);
        if ((++sp & 255u) == 0u) { if (xb_ld(&bar[XB_TMO])) break; if (sp > XB_SPIN_CAP) { atomicAdd(&bar[XB_TMO], 1u); break; } }
    }
    nloc = mine > 0u ? mine : 1u; nx = cnt > 0u ? cnt : 1u;
}

__device__ __forceinline__ void xcd_barrier(const XcdBarrier& b) {
    asm volatile("s_waitcnt vmcnt(0)" ::: "memory");
    __syncthreads();
    if (threadIdx.x == 0) {
        unsigned* bar = b.bar;
        __builtin_amdgcn_s_waitcnt(0);
        unsigned nloc = b.st[0], nx = b.st[1];
        if (nloc == 0u) { xcd_barrier_complete(bar, b.x, nloc, nx); b.st[0] = nloc; b.st[1] = nx; }
        const unsigned old = xb_add(&bar[XB_XSUB(b.x)], 1u);
        const unsigned gen = old / nloc;
        if (old + 1u == (gen + 1u) * nloc) {
            __builtin_amdgcn_fence(__ATOMIC_RELEASE, "agent");
            asm volatile("s_waitcnt vmcnt(0)" ::: "memory");
            const unsigned og = xb_add(&bar[XB_TOP], 1u);
            const unsigned tg = og / nx;
            if (og + 1u == (tg + 1u) * nx) xb_add(&bar[XB_TOPGEN], 1u);
            else XB_SPIN(xb_ld(&bar[XB_TOPGEN]) == tg, bar);
            __builtin_amdgcn_fence(__ATOMIC_ACQUIRE, "agent");
            xb_add(&bar[XB_XGEN(b.x)], 1u);
            asm volatile("s_waitcnt vmcnt(0)" ::: "memory");
        } else {
            XB_SPIN(xb_ld(&bar[XB_XGEN(b.x)]) == gen, bar);
            __builtin_amdgcn_fence(__ATOMIC_ACQUIRE, "agent");
            asm volatile("s_waitcnt vmcnt(0)" ::: "memory");
        }
    }
    __syncthreads();
}

#ifndef STAG_TICKS
#define STAG_TICKS 220
#endif
__device__ __forceinline__ void stagger(int grp) {
    if (grp) { const unsigned long long t0 = __builtin_amdgcn_s_memrealtime(), w = (unsigned long long)grp * STAG_TICKS;
        while (__builtin_amdgcn_s_memrealtime() - t0 < w) __builtin_amdgcn_s_sleep(8); }
}
__global__ void __launch_bounds__(512, 2) fwd(Args a) {
    extern __shared__ __attribute__((aligned(16))) unsigned char lds_raw[];
    LAS unsigned char* lds = (LAS unsigned char*)lds_raw;
    cg::grid_group grid = cg::this_grid();
    const int G = gridDim.x, bx = blockIdx.x, vcu = (G % 8 == 0) ? (bx % 8) * (G / 8) + bx / 8 : bx;
    unsigned char* ws = a.ws;
    bf16_t* Wb; bf16_t* XBF = (bf16_t*)(ws + WS_XBF); float* RS = (float*)(ws + WS_RS);
    bf16_t* Ub = (bf16_t*)(ws + WS_U); bf16_t* Qb = (bf16_t*)(ws + WS_Q); bf16_t* Kb = (bf16_t*)(ws + WS_K); bf16_t* Vb = (bf16_t*)(ws + WS_V);
    bf16_t* Gb = (bf16_t*)(ws + WS_G); bf16_t* YP = (bf16_t*)((unsigned char*)a.out + DO_YP);
    bf16_t* WCOMB;     bf16_t* MRG = (bf16_t*)(ws + WS_MRG); bf16_t* Hb = (bf16_t*)(ws + WS_H);
    unsigned* barw = (unsigned*)ws + 4096;
    if (bx == 0) for (int i = threadIdx.x; i < XCD_BAR_WORDS; i += 512) barw[i] = 0u;
    volatile LAS unsigned* bst = (volatile LAS unsigned*)(lds + 135168);
    if (threadIdx.x < 2) bst[threadIdx.x] = 0u;
    __syncthreads();
    XcdBarrier xbar; xbar.bar = barw; xbar.x = 0; xbar.st = bst;
#define SEAM() xcd_barrier(xbar)
#if PHM & 1
    p0_phase(a, 0, lds, vcu, G);
    p0_phase(a, 1, lds, vcu, G);
#endif
    grid.sync(); xbar = xcd_barrier_post(barw, bst);
    for (int l = 0; l < DEPTH; ++l) {
        Wb = l ? (bf16_t*)(ws + WS_W) : (bf16_t*)((unsigned char*)a.out + DO_W0); WCOMB = (bf16_t*)(ws + (l ? WS_COMB1 : WS_YP));
#if PHM & 2
        {
            pg8::Gemm g{XBF, Wb + WO_CAT, M_, NCAT, 1024, 0, QLD}; pg8::StaticOrder S; S.init(M_, NCAT, G, bx, P1_WGM);
            EpiIn E{Ub, Qb, Kb, Vb, Gb, RS, a.in[5] + l * 64, a.in[6] + l * 64, a.in[12] + (size_t)l * NGATE, 0.f, 0.f};
            pg8::gemm_phase<EpiIn, pg8::StaticOrder, true, true>(lds, g, S, E);
            { const float wq = wave_max(E.nq2), wk = wave_max(E.nk2);
              if ((threadIdx.x & 63) == 0) { float* nm = (float*)(ws + NM_OFF) + (size_t)l * 8192 + ((size_t)bx * 8 + (threadIdx.x >> 6)) * 2; nm[0] = wq; nm[1] = wk; } }
#if PROBE_DUP == 2
            SEAM(); pg8::gemm_phase<EpiIn, pg8::StaticOrder, true, true>(lds, g, S, E);
#endif
#if PROBE_DUP == 12
            SEAM(); { EpiNull EN; pg8::gemm_phase<EpiNull, pg8::StaticOrder, true, true>(lds, g, S, EN); }
#endif
        }
#endif
        SEAM();
#if PHM & 4
        mix_phase(Ub, YP, vcu, G);
#if PROBE_DUP == 3
        grid.sync(); mix_phase(Ub, YP, vcu, G);
#endif
#endif
#if PHM & 8
#if PROBE_DUP == 4
        attn_phase(a, l, lds, bx, 1, a.ws == nullptr); grid.sync();
#endif
        attn_phase(a, l, lds, bx, l);
#endif
        SEAM();
#if PHM & 16
        {
            pg8::StaticOrder S; S.init(M_, 1024, G, bx);
            { pg8::Gemm g{YP, WCOMB, M_, 1024, 1024, 512, QLD}; EpiMerge2 E{Gb, MRG}; pg8::gemm_phase2<EpiMerge2, pg8::StaticOrder, true, true>(lds, g, Qb, Wb + WO_BA, 1024, S, E); }
        }
#endif
        SEAM();
#if PHM & 32
        {
            pg8::Gemm g{MRG, Wb + WO_OUT, M_, 1024, 1024, 0, QLD}; pg8::StaticOrder S; S.init(M_, 1024, G, bx);
            EpiResid E{a.out, XBF, RS, 1};
            pg8::gemm_phase<EpiResid, pg8::StaticOrder, true, true>(lds, g, S, E);
        }
        SEAM();
#endif
#if PHM & 64
        {
            pg8::Gemm g{XBF, Wb + WO_UP, M_, FF, 1024, 0, QLD}; pg8::StaticOrder S; S.init(M_, FF, G, bx);
            EpiUp E{Hb, RS};
#if PROBE_DUP == 13
            { pg8::gemm_phase<EpiUp, pg8::StaticOrder, true, true>(lds, g, S, E); SEAM(); }
#elif PROBE_DUP == 14
            { EpiUpT<1> E1{Hb, RS}; pg8::gemm_phase<EpiUpT<1>, pg8::StaticOrder, true, true>(lds, g, S, E1); SEAM(); }
#elif PROBE_DUP == 15
            { EpiNull EN; pg8::gemm_phase<EpiNull, pg8::StaticOrder, true, true>(lds, g, S, EN); SEAM(); }
#endif
            pg8::gemm_phase<EpiUp, pg8::StaticOrder, true, true>(lds, g, S, E);
#if PROBE_DUP == 6
            grid.sync(); pg8::gemm_phase<EpiUp, pg8::StaticOrder, true, true>(lds, g, S, E);
#endif
        }
        SEAM();
#endif
#if PHM & 128
        {
            pg8::Gemm g{Hb, Wb + WO_DOWN, M_, 1024, FF, 0, HLD}; pg8::StaticOrder S; S.init(M_, 1024, G, bx);
            EpiResid E{a.out, XBF, RS, l + 1 < DEPTH ? 1 : 0};
            pg8::gemm_phase<EpiResid, pg8::StaticOrder, true, true>(lds, g, S, E);
        }
#endif
        if (l + 1 < DEPTH) SEAM();
#if PROBE_DUP == 7
        for (int i = 0; i < 10; ++i) SEAM();
#endif
    }
}
}

extern "C" void kernel_launch(void* const* d_in, const int* in_sizes, int n_in, void* d_out, int out_size, void* d_ws, size_t ws_size, hipStream_t stream) {
    static int grid = 0;
    if (grid == 0) {
        if (n_in != 17 || out_size != mk::M_ * mk::D_ || ws_size < mk::WS_END) { fprintf(stderr, "kernel_launch: unexpected shapes (n_in %d, out %d, ws %zu)\n", n_in, out_size, ws_size); grid = -1; return; }
        int dev = 0, cus = 0, per_cu = 0;
        hipGetDevice(&dev);
        hipDeviceGetAttribute(&cus, hipDeviceAttributeMultiprocessorCount, dev);
        if (hipFuncSetAttribute((const void*)mk::fwd, hipFuncAttributeMaxDynamicSharedMemorySize, mk::LDS_BYTES) != hipSuccess) { fprintf(stderr, "kernel_launch: hipFuncSetAttribute failed\n"); grid = -1; return; }
        hipOccupancyMaxActiveBlocksPerMultiprocessor(&per_cu, (const void*)mk::fwd, 512, mk::LDS_BYTES);
        if (per_cu < 1) { fprintf(stderr, "kernel_launch: occupancy query says 0 blocks per CU\n"); per_cu = 1; }
        (void)hipGetLastError();
        grid = cus;
    }
    if (grid < 0) return;
    mk::Args a{};
    for (int i = 0; i < 17; ++i) a.in[i] = (const float*)d_in[i];
    a.out = (float*)d_out; a.ws = (unsigned char*)d_ws;
    void* args[] = {&a};
    hipError_t e = hipLaunchCooperativeKernel((void*)mk::fwd, dim3(grid), dim3(512), args, mk::LDS_BYTES, stream);
    if (e != hipSuccess) fprintf(stderr, "kernel_launch: cooperative launch failed: %s (grid %d)\n", hipGetErrorString(e), grid);
}
```

```cpp
#include <hip/hip_runtime.h>
#include <hip/hip_cooperative_groups.h>
#include <cstdio>
#include <cstdint>
namespace cg = cooperative_groups;
namespace pg8 {
#define PG8_LAS __attribute__((address_space(3)))
typedef unsigned short bf16_t;
typedef short bf16x8 __attribute__((ext_vector_type(8)));
typedef float f32x4 __attribute__((ext_vector_type(4)));
typedef unsigned u32x4 __attribute__((ext_vector_type(4)));
constexpr int BM = 256, BK = 64, HALF = 128, HTB = HALF * BK * 2  , STAGE_BYTES = 8 * HTB, NXCD = 8, WGM = 8;

__host__ __device__ __forceinline__ int lds_byte(int r, int c) { const int st = (r >> 4) * 2 + (c >> 5), rr = r & 15, cc = c & 31, ob = rr * 64 + cc * 2; return st * 1024 + (ob ^ (((ob >> 9) & 1) << 5)); }
__host__ __device__ __forceinline__ void stage_rc(int b, int& R, int& C) { const int st = b / 1024, sb = b % 1024, swz = sb ^ (((sb >> 9) & 1) << 5); R = (st >> 1) * 16 + swz / 64; C = (st & 1) * 32 + (swz % 64) / 2; }
__host__ __device__ __forceinline__ int perm32(int rho) { const int n = rho >> 4, i = rho & 15; return 8 * (i >> 2) + 4 * n + (i & 3); }

struct Unit { int pm, pn; };
struct Gemm { const bf16_t* A; const bf16_t* Bt; int M, N, K; int N_seg0K = 0; int lda = 0; };

struct StaticOrder {
    int nM, nN, nwg, G, c, wgm;
    __host__ __device__ void init(int M, int N, int G_, int c_, int wgm_ = WGM) { nM = M / BM; nN = N / BM; nwg = nM * nN; G = G_; c = c_; wgm = wgm_; }
    __host__ __device__ bool next(int i, Unit& u) const {
        const long L = (long)i * G + c; if (L >= nwg) return false;
        int wgid = (int)L; { const int q = nwg / NXCD, r = nwg % NXCD, xcd = wgid % NXCD, off = wgid / NXCD; wgid = (xcd < r ? xcd * (q + 1) : r * (q + 1) + (xcd - r) * q) + off; }
        const int nig = wgm * nN, gid = wgid / nig, fm = gid * wgm, gsz = (nM - fm) < wgm ? (nM - fm) : wgm;
        u.pm = fm + ((wgid % nig) % gsz); u.pn = (wgid % nig) / gsz; return true;
    }
    __device__ __forceinline__ void a_ready(const Unit&) const {}
    __device__ __forceinline__ void done(const Unit&) const {}
};
__device__ __forceinline__ unsigned cvt_pk_bf16(float lo, float hi) { unsigned r; asm volatile("v_cvt_pk_bf16_f32 %0, %1, %2" : "=v"(r) : "v"(lo), "v"(hi)); return r; }
typedef float f32x2 __attribute__((ext_vector_type(2)));
template <class Epi, class Sched, bool ALIGN_EPI = false, bool SP2 = false>
__device__ __forceinline__ void gemm_phase(PG8_LAS unsigned char* lds, const Gemm g, const Sched& S, const Epi& E) {
    int tid_ = threadIdx.x; asm volatile("" : "+v"(tid_));
    const int tid = tid_, wid = __builtin_amdgcn_readfirstlane(tid >> 6), lane = tid & 63, wr = wid >> 2, wc = wid & 3, fr = lane & 15, fq = lane >> 4;
    const int K = g.K, nt = K / BK, lda = g.lda ? g.lda : K;
    unsigned voffA[2], voffB[2];
#pragma unroll
    for (int i = 0; i < 2; ++i) { int R, C; stage_rc(tid * 16 + i * 8192, R, C); const int Rb = Epi::PERM ? ((R & ~31) + perm32(R & 31)) : R;
        voffA[i] = (unsigned)(R * lda + C) * 2u; voffB[i] = (unsigned)(Rb * K + C) * 2u; }
    const size_t kstep = (size_t)(BK * 2);
    const size_t hstepA = (size_t)HALF * lda * 2, hstepB = (size_t)HALF * K * 2;
    const size_t tstepA = 2 * hstepA, tstepB = 2 * hstepB;
    const unsigned ldsw = (unsigned)wid * 1024u;
    const int aoff = lds_byte(wr * 64 + fr, fq * 8), boff = lds_byte(wc * 32 + fr, fq * 8);
#define PG8_SA(b, h) (((b) * 2 + (h)) * HTB)
#define PG8_SB(b, h) ((4 + (b) * 2 + (h)) * HTB)
#define PG8_STAGE(bufoff, gbase, voff) do { _Pragma("unroll") for (int _i = 0; _i < 2; ++_i) \
        __builtin_amdgcn_global_load_lds((const unsigned*)((const char*)(gbase) + (voff)[_i]), (PG8_LAS unsigned*)(lds + (bufoff) + ldsw + _i * 8192), 16, 0, 0); } while (0)
#define PG8_LDA(dst, b, h) do { _Pragma("unroll") for (int m = 0; m < 4; ++m) _Pragma("unroll") for (int k = 0; k < 2; ++k) dst[m][k] = *(const PG8_LAS bf16x8*)(lds + PG8_SA(b, h) + aoff + m * 2048 + k * 1024); } while (0)
#define PG8_LDB(dst, b, h) do { _Pragma("unroll") for (int n = 0; n < 2; ++n) _Pragma("unroll") for (int k = 0; k < 2; ++k) dst[n][k] = *(const PG8_LAS bf16x8*)(lds + PG8_SB(b, h) + boff + n * 2048 + k * 1024); } while (0)
#define PG8_MMA(ai, bj, At, Bt) do { __builtin_amdgcn_s_setprio(1); _Pragma("unroll") for (int m = 0; m < 4; ++m) _Pragma("unroll") for (int n = 0; n < 2; ++n) _Pragma("unroll") for (int k = 0; k < 2; ++k) \
        acc[ai][bj][m][n] = __builtin_amdgcn_mfma_f32_16x16x32_bf16(Bt[n][k], At[m][k], acc[ai][bj][m][n], 0, 0, 0); __builtin_amdgcn_s_setprio(0); } while (0)
#define PG8_WAIT_V(n) asm volatile("s_waitcnt vmcnt(" #n ")" ::: "memory")
#define PG8_WAIT_L(n) asm volatile("s_waitcnt lgkmcnt(" #n ")" ::: "memory")
#define PG8_BAR __builtin_amdgcn_s_barrier()
#define PG8_SCHED __builtin_amdgcn_sched_barrier(0)
    Unit cur, nxt; int ui = 0;
    if (!S.next(0, cur)) return;
    f32x4 acc[2][2][4][2];
#pragma unroll
    for (int a = 0; a < 2; ++a)
#pragma unroll
        for (int b = 0; b < 2; ++b)
#pragma unroll
            for (int m = 0; m < 4; ++m)
#pragma unroll
                for (int n = 0; n < 2; ++n) acc[a][b][m][n] = (f32x4){0.f, 0.f, 0.f, 0.f};
    bf16x8 At[4][2], B0[2][2], B1[2][2];
    const char* cA = (const char*)g.A + (size_t)cur.pm * tstepA; const char* cB = (const char*)g.Bt + (size_t)cur.pn * tstepB;
    S.a_ready(cur);
    if constexpr (SP2) {
        PG8_STAGE(PG8_SB(0, 0), cB, voffB); PG8_STAGE(PG8_SB(0, 1), cB + hstepB, voffB); PG8_STAGE(PG8_SA(0, 0), cA, voffA); PG8_STAGE(PG8_SA(0, 1), cA + hstepA, voffA);
        if (wr == 1) PG8_BAR;
        PG8_WAIT_V(2); PG8_BAR;
        PG8_STAGE(PG8_SB(1, 0), cB + kstep, voffB); PG8_STAGE(PG8_SA(1, 0), cA + kstep, voffA); PG8_STAGE(PG8_SB(1, 1), cB + hstepB + kstep, voffB);
        PG8_WAIT_V(6); PG8_BAR;
    } else {
        PG8_STAGE(PG8_SB(0, 0), cB, voffB); PG8_STAGE(PG8_SA(0, 0), cA, voffA); PG8_STAGE(PG8_SB(0, 1), cB + hstepB, voffB); PG8_STAGE(PG8_SA(0, 1), cA + hstepA, voffA);
        if (wr == 1) PG8_BAR;
        PG8_WAIT_V(4); PG8_BAR;
        PG8_STAGE(PG8_SB(1, 0), cB + kstep, voffB); PG8_STAGE(PG8_SA(1, 0), cA + kstep, voffA); PG8_STAGE(PG8_SB(1, 1), cB + hstepB + kstep, voffB);
        PG8_WAIT_V(6); PG8_BAR;
    }
    for (;;) {
        const bool has_next = S.next(ui + 1, nxt);
        const char* nA = has_next ? (const char*)g.A + (size_t)nxt.pm * tstepA : cA; const char* nB = has_next ? (const char*)g.Bt + (size_t)nxt.pn * tstepB : cB;
        for (int t = 0; t < nt; t += 2) {
            const bool last = (t == nt - 2);
            const char* a1 = cA + (size_t)(t + 1) * kstep;
            const char* a2 = last ? nA : cA + (size_t)(t + 2) * kstep; const char* b2 = last ? nB : cB + (size_t)(t + 2) * kstep;
            const char* a3 = a2 + kstep; const char* b3 = b2 + kstep;
            if (last && has_next) S.a_ready(nxt);
            if constexpr (SP2) {
            PG8_LDB(B0, 0, 0); PG8_LDB(B1, 0, 1); PG8_SCHED; PG8_LDA(At, 0, 0); PG8_STAGE(PG8_SA(1, 1), a1 + hstepA, voffA);
            PG8_WAIT_V(8); PG8_WAIT_L(0); PG8_BAR; PG8_MMA(0, 0, At, B0); PG8_MMA(0, 1, At, B1); PG8_BAR; PG8_SCHED;
            PG8_LDA(At, 0, 1); PG8_STAGE(PG8_SB(0, 0), b2, voffB); PG8_STAGE(PG8_SB(0, 1), b2 + hstepB, voffB); PG8_STAGE(PG8_SA(0, 0), a2, voffA);
            PG8_WAIT_V(8); PG8_WAIT_L(0); PG8_BAR; PG8_MMA(1, 0, At, B0); PG8_MMA(1, 1, At, B1); PG8_BAR; PG8_SCHED;
            PG8_LDB(B0, 1, 0); PG8_LDB(B1, 1, 1); PG8_SCHED; PG8_LDA(At, 1, 0); PG8_STAGE(PG8_SA(0, 1), a2 + hstepA, voffA);
            PG8_WAIT_V(8); PG8_WAIT_L(0); PG8_BAR; PG8_MMA(0, 0, At, B0); PG8_MMA(0, 1, At, B1); PG8_BAR; PG8_SCHED;
            PG8_LDA(At, 1, 1); PG8_STAGE(PG8_SB(1, 0), b3, voffB); PG8_STAGE(PG8_SB(1, 1), b3 + hstepB, voffB); PG8_STAGE(PG8_SA(1, 0), a3, voffA);
            PG8_WAIT_V(8); PG8_WAIT_L(0); PG8_BAR; PG8_MMA(1, 0, At, B0); PG8_MMA(1, 1, At, B1); PG8_BAR; PG8_SCHED;
            } else {
            PG8_LDB(B0, 0, 0); PG8_SCHED; PG8_LDA(At, 0, 0); PG8_STAGE(PG8_SA(1, 1), a1 + hstepA, voffA);
            PG8_WAIT_L(8); PG8_BAR; PG8_WAIT_L(0); PG8_MMA(0, 0, At, B0); PG8_BAR; PG8_SCHED;
            PG8_LDB(B1, 0, 1); PG8_STAGE(PG8_SB(0, 0), b2, voffB);
            PG8_BAR; PG8_WAIT_L(0); PG8_MMA(0, 1, At, B1); PG8_BAR;
            PG8_LDA(At, 0, 1); PG8_STAGE(PG8_SA(0, 0), a2, voffA);
            PG8_BAR; PG8_WAIT_L(0); PG8_MMA(1, 0, At, B0); PG8_BAR; PG8_SCHED;
            PG8_STAGE(PG8_SB(0, 1), b2 + hstepB, voffB);
            PG8_WAIT_V(6); PG8_BAR; PG8_MMA(1, 1, At, B1); PG8_BAR;
            PG8_LDB(B0, 1, 0); PG8_SCHED; PG8_LDA(At, 1, 0); PG8_STAGE(PG8_SA(0, 1), a2 + hstepA, voffA);
            PG8_WAIT_L(8); PG8_BAR; PG8_WAIT_L(0); PG8_MMA(0, 0, At, B0); PG8_BAR; PG8_SCHED;
            PG8_LDB(B1, 1, 1); PG8_STAGE(PG8_SB(1, 0), b3, voffB);
            PG8_BAR; PG8_WAIT_L(0); PG8_MMA(0, 1, At, B1); PG8_BAR;
            PG8_LDA(At, 1, 1); PG8_STAGE(PG8_SA(1, 0), a3, voffA);
            PG8_BAR; PG8_WAIT_L(0); PG8_MMA(1, 0, At, B0); PG8_BAR; PG8_SCHED;
            PG8_STAGE(PG8_SB(1, 1), b3 + hstepB, voffB);
            PG8_WAIT_V(6); PG8_BAR; PG8_MMA(1, 1, At, B1); PG8_BAR;
            }
        }
        if constexpr (ALIGN_EPI) { if (wr == 0) PG8_BAR; }
        if constexpr (!Epi::AFTER_DRAIN) { E(acc, cur, wr, wc, fr, fq); S.done(cur); }
        if (!has_next) break;
#pragma unroll
        for (int a = 0; a < 2; ++a)
#pragma unroll
            for (int b = 0; b < 2; ++b)
#pragma unroll
                for (int m = 0; m < 4; ++m)
#pragma unroll
                    for (int n = 0; n < 2; ++n) acc[a][b][m][n] = (f32x4){0.f, 0.f, 0.f, 0.f};
        cur = nxt; cA = nA; cB = nB; ++ui;
        if constexpr (ALIGN_EPI) { if (wr == 1) PG8_BAR; }
    }
    PG8_WAIT_V(0);
    if constexpr (!ALIGN_EPI) { if (wr == 0) PG8_BAR; }
    PG8_BAR;
    if constexpr (Epi::AFTER_DRAIN) { E.fused(acc, cur, wr, wc, fr, fq, lds, wid, lane); S.done(cur); }
}
template <class Epi, class Sched, bool ALIGN_EPI = false, bool SP2 = false>
__device__ __forceinline__ void gemm_phase2(PG8_LAS unsigned char* lds, const Gemm g, const bf16_t* A1, const bf16_t* Bt1, int K1, const Sched& S, const Epi& E) {
    int tid_ = threadIdx.x; asm volatile("" : "+v"(tid_));
    const int tid = tid_, wid = __builtin_amdgcn_readfirstlane(tid >> 6), lane = tid & 63, wr = wid >> 2, wc = wid & 3, fr = lane & 15, fq = lane >> 4;
    const int K = g.K  , lda = g.lda ? g.lda : K  , nt0 = g.N_seg0K / BK, nt1 = K1 / BK;
    unsigned voffA[2], voffB[2];
#pragma unroll
    for (int i = 0; i < 2; ++i) { int R, C; stage_rc(tid * 16 + i * 8192, R, C); const int Rb = Epi::PERM ? ((R & ~31) + perm32(R & 31)) : R;
        voffA[i] = (unsigned)(R * lda + C) * 2u; voffB[i] = (unsigned)(Rb * K + C) * 2u; }
    const size_t kstep = (size_t)(BK * 2);
    const size_t hstepA = (size_t)HALF * lda * 2, hstepB = (size_t)HALF * K * 2;
    const size_t tstepA = 2 * hstepA, tstepB = 2 * hstepB;
    const unsigned ldsw = (unsigned)wid * 1024u;
    const int aoff = lds_byte(wr * 64 + fr, fq * 8), boff = lds_byte(wc * 32 + fr, fq * 8);
#define PG8_SA(b, h) (((b) * 2 + (h)) * HTB)
#define PG8_SB(b, h) ((4 + (b) * 2 + (h)) * HTB)
#define PG8_STAGE(bufoff, gbase, voff) do { _Pragma("unroll") for (int _i = 0; _i < 2; ++_i) \
        __builtin_amdgcn_global_load_lds((const unsigned*)((const char*)(gbase) + (voff)[_i]), (PG8_LAS unsigned*)(lds + (bufoff) + ldsw + _i * 8192), 16, 0, 0); } while (0)
#define PG8_LDA(dst, b, h) do { _Pragma("unroll") for (int m = 0; m < 4; ++m) _Pragma("unroll") for (int k = 0; k < 2; ++k) dst[m][k] = *(const PG8_LAS bf16x8*)(lds + PG8_SA(b, h) + aoff + m * 2048 + k * 1024); } while (0)
#define PG8_LDB(dst, b, h) do { _Pragma("unroll") for (int n = 0; n < 2; ++n) _Pragma("unroll") for (int k = 0; k < 2; ++k) dst[n][k] = *(const PG8_LAS bf16x8*)(lds + PG8_SB(b, h) + boff + n * 2048 + k * 1024); } while (0)
#define PG8_MMA(ai, bj, At, Bt) do { __builtin_amdgcn_s_setprio(1); _Pragma("unroll") for (int m = 0; m < 4; ++m) _Pragma("unroll") for (int n = 0; n < 2; ++n) _Pragma("unroll") for (int k = 0; k < 2; ++k) \
        acc[ai][bj][m][n] = __builtin_amdgcn_mfma_f32_16x16x32_bf16(Bt[n][k], At[m][k], acc[ai][bj][m][n], 0, 0, 0); __builtin_amdgcn_s_setprio(0); } while (0)
#define PG8_WAIT_V(n) asm volatile("s_waitcnt vmcnt(" #n ")" ::: "memory")
#define PG8_WAIT_L(n) asm volatile("s_waitcnt lgkmcnt(" #n ")" ::: "memory")
#define PG8_BAR __builtin_amdgcn_s_barrier()
#define PG8_SCHED __builtin_amdgcn_sched_barrier(0)
    Unit cur, nxt; int ui = 0; int cseg = 0;
    if (!S.next(0, cur)) return;
    f32x4 acc[2][2][4][2];
#pragma unroll
    for (int a = 0; a < 2; ++a)
#pragma unroll
        for (int b = 0; b < 2; ++b)
#pragma unroll
            for (int m = 0; m < 4; ++m)
#pragma unroll
                for (int n = 0; n < 2; ++n) acc[a][b][m][n] = (f32x4){0.f, 0.f, 0.f, 0.f};
    bf16x8 At[4][2], B0[2][2], B1[2][2];
    const char* cA = (const char*)g.A + (size_t)cur.pm * tstepA; const char* cB = (const char*)g.Bt + (size_t)cur.pn * tstepB;
    if constexpr (SP2) {
        PG8_STAGE(PG8_SB(0, 0), cB, voffB); PG8_STAGE(PG8_SB(0, 1), cB + hstepB, voffB); PG8_STAGE(PG8_SA(0, 0), cA, voffA); PG8_STAGE(PG8_SA(0, 1), cA + hstepA, voffA);
        if (wr == 1) PG8_BAR;
        PG8_WAIT_V(2); PG8_BAR;
        PG8_STAGE(PG8_SB(1, 0), cB + kstep, voffB); PG8_STAGE(PG8_SA(1, 0), cA + kstep, voffA); PG8_STAGE(PG8_SB(1, 1), cB + hstepB + kstep, voffB);
        PG8_WAIT_V(6); PG8_BAR;
    } else {
        PG8_STAGE(PG8_SB(0, 0), cB, voffB); PG8_STAGE(PG8_SA(0, 0), cA, voffA); PG8_STAGE(PG8_SB(0, 1), cB + hstepB, voffB); PG8_STAGE(PG8_SA(0, 1), cA + hstepA, voffA);
        if (wr == 1) PG8_BAR;
        PG8_WAIT_V(4); PG8_BAR;
        PG8_STAGE(PG8_SB(1, 0), cB + kstep, voffB); PG8_STAGE(PG8_SA(1, 0), cA + kstep, voffA); PG8_STAGE(PG8_SB(1, 1), cB + hstepB + kstep, voffB);
        PG8_WAIT_V(6); PG8_BAR;
    }
    for (;;) {
        const int nseg = cseg ^ 1; bool has_next; if (cseg == 0) { nxt = cur; has_next = true; } else has_next = S.next((ui >> 1) + 1, nxt);
        const int nt = cseg ? nt1 : nt0;
        const char* nA = has_next ? (const char*)(nseg ? A1 : g.A) + (size_t)nxt.pm * tstepA : cA; const char* nB = has_next ? (const char*)(nseg ? Bt1 : g.Bt) + (size_t)nxt.pn * tstepB : cB;
        for (int t = 0; t < nt; t += 2) {
            const bool last = (t == nt - 2);
            const char* a1 = cA + (size_t)(t + 1) * kstep;
            const char* a2 = last ? nA : cA + (size_t)(t + 2) * kstep; const char* b2 = last ? nB : cB + (size_t)(t + 2) * kstep;
            const char* a3 = a2 + kstep; const char* b3 = b2 + kstep;
            if constexpr (SP2) {
            PG8_LDB(B0, 0, 0); PG8_LDB(B1, 0, 1); PG8_SCHED; PG8_LDA(At, 0, 0); PG8_STAGE(PG8_SA(1, 1), a1 + hstepA, voffA);
            PG8_WAIT_V(8); PG8_WAIT_L(0); PG8_BAR; PG8_MMA(0, 0, At, B0); PG8_MMA(0, 1, At, B1); PG8_BAR; PG8_SCHED;
            PG8_LDA(At, 0, 1); PG8_STAGE(PG8_SB(0, 0), b2, voffB); PG8_STAGE(PG8_SB(0, 1), b2 + hstepB, voffB); PG8_STAGE(PG8_SA(0, 0), a2, voffA);
            PG8_WAIT_V(8); PG8_WAIT_L(0); PG8_BAR; PG8_MMA(1, 0, At, B0); PG8_MMA(1, 1, At, B1); PG8_BAR; PG8_SCHED;
            PG8_LDB(B0, 1, 0); PG8_LDB(B1, 1, 1); PG8_SCHED; PG8_LDA(At, 1, 0); PG8_STAGE(PG8_SA(0, 1), a2 + hstepA, voffA);
            PG8_WAIT_V(8); PG8_WAIT_L(0); PG8_BAR; PG8_MMA(0, 0, At, B0); PG8_MMA(0, 1, At, B1); PG8_BAR; PG8_SCHED;
            PG8_LDA(At, 1, 1); PG8_STAGE(PG8_SB(1, 0), b3, voffB); PG8_STAGE(PG8_SB(1, 1), b3 + hstepB, voffB); PG8_STAGE(PG8_SA(1, 0), a3, voffA);
            PG8_WAIT_V(8); PG8_WAIT_L(0); PG8_BAR; PG8_MMA(1, 0, At, B0); PG8_MMA(1, 1, At, B1); PG8_BAR; PG8_SCHED;
            } else {
            PG8_LDB(B0, 0, 0); PG8_SCHED; PG8_LDA(At, 0, 0); PG8_STAGE(PG8_SA(1, 1), a1 + hstepA, voffA);
            PG8_WAIT_L(8); PG8_BAR; PG8_WAIT_L(0); PG8_MMA(0, 0, At, B0); PG8_BAR; PG8_SCHED;
            PG8_LDB(B1, 0, 1); PG8_STAGE(PG8_SB(0, 0), b2, voffB);
            PG8_BAR; PG8_WAIT_L(0); PG8_MMA(0, 1, At, B1); PG8_BAR;
            PG8_LDA(At, 0, 1); PG8_STAGE(PG8_SA(0, 0), a2, voffA);
            PG8_BAR; PG8_WAIT_L(0); PG8_MMA(1, 0, At, B0); PG8_BAR; PG8_SCHED;
            PG8_STAGE(PG8_SB(0, 1), b2 + hstepB, voffB);
            PG8_WAIT_V(6); PG8_BAR; PG8_MMA(1, 1, At, B1); PG8_BAR;
            PG8_LDB(B0, 1, 0); PG8_SCHED; PG8_LDA(At, 1, 0); PG8_STAGE(PG8_SA(0, 1), a2 + hstepA, voffA);
            PG8_WAIT_L(8); PG8_BAR; PG8_WAIT_L(0); PG8_MMA(0, 0, At, B0); PG8_BAR; PG8_SCHED;
            PG8_LDB(B1, 1, 1); PG8_STAGE(PG8_SB(1, 0), b3, voffB);
            PG8_BAR; PG8_WAIT_L(0); PG8_MMA(0, 1, At, B1); PG8_BAR;
            PG8_LDA(At, 1, 1); PG8_STAGE(PG8_SA(1, 0), a3, voffA);
            PG8_BAR; PG8_WAIT_L(0); PG8_MMA(1, 0, At, B0); PG8_BAR; PG8_SCHED;
            PG8_STAGE(PG8_SB(1, 1), b3 + hstepB, voffB);
            PG8_WAIT_V(6); PG8_BAR; PG8_MMA(1, 1, At, B1); PG8_BAR;
            }
        }
        if constexpr (ALIGN_EPI) { if (wr == 0) PG8_BAR; }
        if (cseg == 0) E.mid(acc, cur, wr, wc, fr, fq); else E(acc, cur, wr, wc, fr, fq);
        if (!has_next) break;
        if (cseg == 1) {
#pragma unroll
        for (int a = 0; a < 2; ++a)
#pragma unroll
            for (int b = 0; b < 2; ++b)
#pragma unroll
                for (int m = 0; m < 4; ++m)
#pragma unroll
                    for (int n = 0; n < 2; ++n) acc[a][b][m][n] = (f32x4){0.f, 0.f, 0.f, 0.f};
        }
        cur = nxt; cA = nA; cB = nB; ++ui; cseg = nseg;
        if constexpr (ALIGN_EPI) { if (wr == 1) PG8_BAR; }
    }
    PG8_WAIT_V(0);
    if constexpr (!ALIGN_EPI) { if (wr == 0) PG8_BAR; }
    PG8_BAR;
#undef PG8_SA
#undef PG8_SB
#undef PG8_STAGE
#undef PG8_LDA
#undef PG8_LDB
#undef PG8_MMA
#undef PG8_WAIT_V
#undef PG8_WAIT_L
#undef PG8_BAR
#undef PG8_SCHED
}
}
#ifndef PHM
#define PHM 255
#endif
#ifndef PROBE_DUP
#define PROBE_DUP 0
#endif
#ifndef P1_WGM
#define P1_WGM 8
#endif
namespace mk {
__device__ __forceinline__ int fresh_tid() { int t = threadIdx.x; asm volatile("" : "+v"(t)); return t; }
using pg8::bf16_t; using pg8::f32x4; using pg8::u32x4; using pg8::Unit;
#define LAS __attribute__((address_space(3)))
typedef short bf16x8 __attribute__((ext_vector_type(8)));
typedef float f32x16 __attribute__((ext_vector_type(16)));
typedef short s16x4 __attribute__((ext_vector_type(4)));
typedef short v4i16_t __attribute__((ext_vector_type(4)));

constexpr int NB = 8, S_ = 4096, D_ = 1024, M_ = NB * S_, IN_ = 3584, NGATE = 2048, NCAT = IN_ + NGATE, FF = 4096, POOL = 512, DEPTH = 2;
constexpr float EPS = 1e-6f, LOG2E = 1.4426950408889634f;
constexpr size_t MiB = 1u << 20;
constexpr int QLD = 1152, GLD = 2176, ULD = 640;
constexpr size_t WS_RS = 1 * MiB;
constexpr size_t WS_W = 3 * MiB;
constexpr size_t WO_CAT = 0, WO_COMB = (size_t)NCAT * 1024, WO_BA = WO_COMB + 1024 * 512, WO_OUT = WO_BA + 1024 * 1024, WO_UP = WO_OUT + 1024 * 1024, WO_DOWN = WO_UP + 4096 * 1024;
constexpr size_t WS_XBF = 35 * MiB;
constexpr size_t WS_U = 107 * MiB;
constexpr size_t WS_Q = 147 * MiB;
constexpr size_t WS_K = 219 * MiB;
constexpr size_t WS_V = 291 * MiB;
constexpr size_t WS_G = 363 * MiB;
constexpr size_t WS_YP = 499 * MiB;
constexpr size_t WS_MRG = WS_K;
constexpr size_t WS_H = WS_U;
constexpr size_t WS_COMB1 = 501 * MiB;
constexpr size_t WS_END = 503 * MiB;
constexpr size_t DO_YP = 0, DO_W0 = 80 * MiB;
constexpr int LDS_BYTES = 147456;
constexpr size_t NM_OFF = 512 * 1024;
constexpr int HLD = FF + 128;  static_assert(WS_H + (size_t)M_ * HLD * 2 <= WS_YP && WS_G + (size_t)M_ * GLD * 2 <= WS_YP, "ws map");

__device__ __forceinline__ unsigned pk2(float lo, float hi) { return pg8::cvt_pk_bf16(lo, hi); }
__device__ __forceinline__ float bflo(unsigned w) { return __uint_as_float(w << 16); }
__device__ __forceinline__ float bfhi(unsigned w) { return __uint_as_float(w & 0xffff0000u); }
__device__ __forceinline__ float wave_sum(float v) {
#pragma unroll
    for (int o = 1; o < 64; o <<= 1) v += __shfl_xor(v, o);
    return v;
}
__device__ __forceinline__ float wave_max(float v) {
#pragma unroll
    for (int o = 1; o < 64; o <<= 1) v = fmaxf(v, __shfl_xor(v, o));
    return v;
}
__device__ __forceinline__ float rstd_row(const float* RS, int row, int fq) {
    const f32x4 v = *(const f32x4*)(RS + (size_t)row * 16 + 4 * fq);
    float s = (v[0] + v[1]) + (v[2] + v[3]);
    s += __shfl_xor(s, 16); s += __shfl_xor(s, 32);
    return rsqrtf(s * (1.0f / 1024.0f) + EPS);
}
typedef float f32x2 __attribute__((ext_vector_type(2)));
__device__ __forceinline__ float msq_row(const float* RS, int row, int fq) {
    const f32x4 v = *(const f32x4*)(RS + (size_t)row * 16 + 4 * fq);
    float s = (v[0] + v[1]) + (v[2] + v[3]);
    s += __shfl_xor(s, 16); s += __shfl_xor(s, 32);
    return s * (1.0f / 1024.0f) + EPS;
}
__device__ __forceinline__ float sigmoidf_(float z) { return __builtin_amdgcn_rcpf(1.0f + __builtin_amdgcn_exp2f(-z * LOG2E)); }

struct EpiIn {
    static constexpr bool PERM = true, AFTER_DRAIN = false;
    bf16_t *U, *Q, *K, *V, *G; const float* RS; const float* gq; const float* gk; const float* bgate; mutable float nq2, nk2;
    __device__ __forceinline__ void operator()(const f32x4 (&acc)[2][2][4][2], const Unit& u, int wr, int wc, int fr, int fq) const {
        const int row0 = u.pm * 256 + wr * 64 + fr, pn = u.pn;
        if (pn >= 2 && pn < 10) {
            const bool isq = pn < 6; bf16_t* base = isq ? Q : K; const int colt = (pn - (isq ? 2 : 6)) * 256 + 64 * wc + 8 * fq;
            const float* g = isq ? gq : gk; const float sc = isq ? 0.125f * LOG2E : 1.0f;
            f32x4 gv[2][2];
#pragma unroll
            for (int bj = 0; bj < 2; ++bj)
#pragma unroll
                for (int n = 0; n < 2; ++n) gv[bj][n] = *(const f32x4*)(g + 32 * bj + 8 * fq + 4 * n) * sc;
            float nmx = 0.f;
#pragma unroll
            for (int ai = 0; ai < 2; ++ai)
#pragma unroll
                for (int m = 0; m < 4; ++m) {
                    const int row = row0 + ai * 128 + m * 16; const float ir2 = msq_row(RS, row, fq);
                    f32x2 s2 = {0.f, 0.f};
#pragma unroll
                    for (int bj = 0; bj < 2; ++bj)
#pragma unroll
                        for (int n = 0; n < 2; ++n) { const f32x4 a = acc[ai][bj][m][n]; const f32x2 lo = {a[0], a[1]}, hi2 = {a[2], a[3]}; s2 = lo * lo + s2; s2 = hi2 * hi2 + s2; }
                    float ss = s2[0] + s2[1];
                    ss += __shfl_xor(ss, 16); ss += __shfl_xor(ss, 32);
                    const float rn = rsqrtf(ss * (1.0f / 64.0f) + EPS * ir2);
                    const f32x2 rn2 = {rn, rn};
                    bf16_t* rowp = base + (size_t)row * QLD + colt; f32x2 nn = {0.f, 0.f};
#pragma unroll
                    for (int bj = 0; bj < 2; ++bj) {
                        const f32x4 a0 = acc[ai][bj][m][0], a1 = acc[ai][bj][m][1], g0 = gv[bj][0], g1 = gv[bj][1];
                        const f32x2 p0 = (f32x2){a0[0], a0[1]} * ((f32x2){g0[0], g0[1]} * rn2), p1 = (f32x2){a0[2], a0[3]} * ((f32x2){g0[2], g0[3]} * rn2);
                        const f32x2 p2 = (f32x2){a1[0], a1[1]} * ((f32x2){g1[0], g1[1]} * rn2), p3 = (f32x2){a1[2], a1[3]} * ((f32x2){g1[2], g1[3]} * rn2);
                        nn = p0 * p0 + nn; nn = p1 * p1 + nn; nn = p2 * p2 + nn; nn = p3 * p3 + nn;
                        u32x4 w; w.x = pk2(p0[0], p0[1]); w.y = pk2(p1[0], p1[1]); w.z = pk2(p2[0], p2[1]); w.w = pk2(p3[0], p3[1]);
                        __builtin_nontemporal_store(w, (u32x4*)(rowp + 32 * bj)); }
                    float n2 = nn[0] + nn[1]; n2 += __shfl_xor(n2, 16); n2 += __shfl_xor(n2, 32);
                    nmx = fmaxf(nmx, n2);
                }
            if (isq) nq2 = fmaxf(nq2, nmx); else nk2 = fmaxf(nk2, nmx);
        } else {
            bf16_t* base; int ld, colt; bool sg = false;
            if (pn < 2) { base = U; ld = ULD; colt = pn * 256; } else if (pn < 14) { base = V; ld = QLD; colt = (pn - 10) * 256; } else { base = G; ld = GLD; colt = (pn - 14) * 256; sg = true; }
            const int col0 = colt + wc * 32 + 8 * fq;
            f32x4 bv[2][2];
#pragma unroll
            for (int bj = 0; bj < 2; ++bj)
#pragma unroll
                for (int n = 0; n < 2; ++n) bv[bj][n] = sg ? *(const f32x4*)(bgate + col0 + bj * 128 + 4 * n) * (-LOG2E) : (f32x4){0.f, 0.f, 0.f, 0.f};
#pragma unroll
            for (int ai = 0; ai < 2; ++ai)
#pragma unroll
                for (int m = 0; m < 4; ++m) {
                    const int row = row0 + ai * 128 + m * 16; const float r = rstd_row(RS, row, fq) * (sg ? -LOG2E : 1.0f);
                    const f32x2 r2 = {r, r}, one2 = {1.0f, 1.0f};
                    bf16_t* rowp = base + (size_t)row * ld + col0;
#pragma unroll
                    for (int bj = 0; bj < 2; ++bj) {
                        const f32x4 a0 = acc[ai][bj][m][0], a1 = acc[ai][bj][m][1], b0 = bv[bj][0], b1 = bv[bj][1];
                        f32x2 p0 = (f32x2){a0[0], a0[1]} * r2 + (f32x2){b0[0], b0[1]}, p1 = (f32x2){a0[2], a0[3]} * r2 + (f32x2){b0[2], b0[3]};
                        f32x2 p2 = (f32x2){a1[0], a1[1]} * r2 + (f32x2){b1[0], b1[1]}, p3 = (f32x2){a1[2], a1[3]} * r2 + (f32x2){b1[2], b1[3]};
                        if (sg) {
#define MK_SG(p) do { p[0] = __builtin_amdgcn_exp2f(p[0]); p[1] = __builtin_amdgcn_exp2f(p[1]); p = p + one2; p[0] = __builtin_amdgcn_rcpf(p[0]); p[1] = __builtin_amdgcn_rcpf(p[1]); } while (0)
                            MK_SG(p0); MK_SG(p1); MK_SG(p2); MK_SG(p3);
#undef MK_SG
                        }
                        u32x4 w; w.x = pk2(p0[0], p0[1]); w.y = pk2(p1[0], p1[1]); w.z = pk2(p2[0], p2[1]); w.w = pk2(p3[0], p3[1]);
                        __builtin_nontemporal_store(w, (u32x4*)(rowp + bj * 128)); }
                }
        }
    }
};
struct EpiMerge2 {
    static constexpr bool PERM = true, AFTER_DRAIN = false;
    const bf16_t* G; bf16_t* MRG;
    __device__ __forceinline__ void mid(f32x4 (&acc)[2][2][4][2], const Unit& u, int wr, int wc, int fr, int fq) const {
        const int row0 = u.pm * 256 + wr * 64 + fr, col0 = u.pn * 256 + wc * 32 + 8 * fq;
#pragma unroll
        for (int ai = 0; ai < 2; ++ai)
#pragma unroll
            for (int m = 0; m < 4; ++m) {
                const int row = row0 + ai * 128 + m * 16;
#pragma unroll
                for (int bj = 0; bj < 2; ++bj) {
                    const bf16_t* gp = G + (size_t)row * GLD + col0 + bj * 128;
                    const u32x4 g0 = *(const u32x4*)gp, g1 = *(const u32x4*)(gp + 1024);
#define MK_RT(a, b) ((a) * __builtin_amdgcn_rcpf(fmaxf((b), 1e-30f)))
                    f32x4& v0 = acc[ai][bj][m][0]; f32x4& v1 = acc[ai][bj][m][1];
                    v0[0] *= MK_RT(bflo(g0.x), bflo(g1.x)); v0[1] *= MK_RT(bfhi(g0.x), bfhi(g1.x)); v0[2] *= MK_RT(bflo(g0.y), bflo(g1.y)); v0[3] *= MK_RT(bfhi(g0.y), bfhi(g1.y));
                    v1[0] *= MK_RT(bflo(g0.z), bflo(g1.z)); v1[1] *= MK_RT(bfhi(g0.z), bfhi(g1.z)); v1[2] *= MK_RT(bflo(g0.w), bflo(g1.w)); v1[3] *= MK_RT(bfhi(g0.w), bfhi(g1.w));
#undef MK_RT
                }
            }
    }
    __device__ __forceinline__ void operator()(const f32x4 (&acc)[2][2][4][2], const Unit& u, int wr, int wc, int fr, int fq) const {
        const int row0 = u.pm * 256 + wr * 64 + fr, col0 = u.pn * 256 + wc * 32 + 8 * fq;
#pragma unroll
        for (int ai = 0; ai < 2; ++ai)
#pragma unroll
            for (int m = 0; m < 4; ++m) {
                const int row = row0 + ai * 128 + m * 16;
#pragma unroll
                for (int bj = 0; bj < 2; ++bj) {
                    const u32x4 gw = *(const u32x4*)(G + (size_t)row * GLD + 1024 + col0 + bj * 128);
                    f32x4 v0 = acc[ai][bj][m][0], v1 = acc[ai][bj][m][1];
                    v0[0] *= bflo(gw.x); v0[1] *= bfhi(gw.x); v0[2] *= bflo(gw.y); v0[3] *= bfhi(gw.y);
                    v1[0] *= bflo(gw.z); v1[1] *= bfhi(gw.z); v1[2] *= bflo(gw.w); v1[3] *= bfhi(gw.w);
                    u32x4 w; w.x = pk2(v0[0], v0[1]); w.y = pk2(v0[2], v0[3]); w.z = pk2(v1[0], v1[1]); w.w = pk2(v1[2], v1[3]);
                    *(u32x4*)(MRG + (size_t)row * QLD + col0 + bj * 128) = w; }
            }
    }
};
struct EpiResid {
    static constexpr bool PERM = true, AFTER_DRAIN = false;
    float* out; bf16_t* xbf; float* RS; int wr_aux;
    __device__ __forceinline__ void operator()(const f32x4 (&acc)[2][2][4][2], const Unit& u, int wr, int wc, int fr, int fq) const {
        const int row0 = u.pm * 256 + wr * 64 + fr, col0 = u.pn * 256 + wc * 32 + 8 * fq;
#pragma unroll
        for (int ai = 0; ai < 2; ++ai)
#pragma unroll
            for (int m = 0; m < 4; ++m) {
                const int row = row0 + ai * 128 + m * 16; float ss = 0.f;
#pragma unroll
                for (int bj = 0; bj < 2; ++bj) {
                    const size_t off = (size_t)row * 1024 + col0 + bj * 128, xoff = (size_t)row * QLD + col0 + bj * 128;
                    const u32x4 xw = *(const u32x4*)(xbf + xoff);
                    f32x4 v0 = acc[ai][bj][m][0], v1 = acc[ai][bj][m][1];
                    v0[0] += bflo(xw.x); v0[1] += bfhi(xw.x); v0[2] += bflo(xw.y); v0[3] += bfhi(xw.y);
                    v1[0] += bflo(xw.z); v1[1] += bfhi(xw.z); v1[2] += bflo(xw.w); v1[3] += bfhi(xw.w);
                    if (wr_aux) {
                        const f32x4 q0 = v0 * v0, q1 = v1 * v1; ss += ((q0[0] + q0[1]) + (q0[2] + q0[3])) + ((q1[0] + q1[1]) + (q1[2] + q1[3]));
                        u32x4 w; w.x = pk2(v0[0], v0[1]); w.y = pk2(v0[2], v0[3]); w.z = pk2(v1[0], v1[1]); w.w = pk2(v1[2], v1[3]);
                        *(u32x4*)(xbf + xoff) = w;
                    } else { *(f32x4*)(out + off) = v0; *(f32x4*)(out + off + 4) = v1; }
                }
                if (wr_aux) { ss += __shfl_xor(ss, 16); ss += __shfl_xor(ss, 32); if (fq == 0) RS[(size_t)row * 16 + u.pn * 4 + wc] = ss; }
            }
    }
};
struct EpiNull {
    static constexpr bool PERM = true, AFTER_DRAIN = false;
    __device__ __forceinline__ void operator()(const f32x4 (&acc)[2][2][4][2], const Unit& u, int wr, int wc, int fr, int fq) const {
#pragma unroll
        for (int ai = 0; ai < 2; ++ai)
#pragma unroll
            for (int bj = 0; bj < 2; ++bj)
#pragma unroll
                for (int m = 0; m < 4; ++m) asm volatile("" :: "v"(acc[ai][bj][m][0]), "v"(acc[ai][bj][m][1]));
    }
};
template <int NORS> struct EpiUpT {
    static constexpr bool PERM = true, AFTER_DRAIN = false;
    bf16_t* H; const float* RS;
    __device__ __forceinline__ void operator()(const f32x4 (&acc)[2][2][4][2], const Unit& u, int wr, int wc, int fr, int fq) const {
        const int row0 = u.pm * 256 + wr * 64 + fr, col0 = u.pn * 256 + wc * 32 + 8 * fq;
#pragma unroll
        for (int ai = 0; ai < 2; ++ai)
#pragma unroll
            for (int m = 0; m < 4; ++m) {
                const int row = row0 + ai * 128 + m * 16; const float r = NORS ? 1.0f : rstd_row(RS, row, fq);
                const f32x2 rr = {r * r, r * r};
#pragma unroll
                for (int bj = 0; bj < 2; ++bj) {
                    const f32x4 a0 = acc[ai][bj][m][0], a1 = acc[ai][bj][m][1];
#define MK_R2(x, y) (((f32x2){x, y} * (f32x2){fmaxf(x, 0.f), fmaxf(y, 0.f)}) * rr)
                    const f32x2 p0 = MK_R2(a0[0], a0[1]), p1 = MK_R2(a0[2], a0[3]), p2 = MK_R2(a1[0], a1[1]), p3 = MK_R2(a1[2], a1[3]);
#undef MK_R2
                    u32x4 w; w.x = pk2(p0[0], p0[1]); w.y = pk2(p1[0], p1[1]); w.z = pk2(p2[0], p2[1]); w.w = pk2(p3[0], p3[1]);
                    __builtin_nontemporal_store(w, (u32x4*)(H + (size_t)row * HLD + col0 + bj * 128)); }
            }
    }
};
typedef EpiUpT<0> EpiUp;
__device__ __forceinline__ int qk_perm_row(int n) {
    if (n < 512 || n >= 2560) return n;
    const int c = n - 512; return 512 + (c & ~255) + 128 * ((c >> 5) & 1) + 32 * ((c >> 6) & 3) + (c & 31);
}
__device__ __forceinline__ void transpose_item(const float* W, int K, int N, bf16_t* WT, int row_off, const float* gk, bool permqk, LAS float* scr, int item, int lane) {
    const int nblk = N / 64, kb = item / nblk, nb = item % nblk, k0 = 64 * kb, n0 = 64 * nb, kr = lane >> 4, nc = lane & 15;
    f32x4 v[16];
#pragma unroll
    for (int i = 0; i < 16; ++i) v[i] = *(const f32x4*)(W + (size_t)(k0 + 4 * i + kr) * N + n0 + 4 * nc);
    if (gk) {
#pragma unroll
        for (int i = 0; i < 16; ++i) v[i] = v[i] * gk[k0 + 4 * i + kr];
    }
#pragma unroll
    for (int i = 0; i < 16; ++i)
#pragma unroll
        for (int e = 0; e < 4; ++e) scr[(4 * nc + e) * 65 + 4 * i + kr] = v[i][e];
    asm volatile("s_waitcnt lgkmcnt(0)" ::: "memory");
    const int c = lane & 7;
#pragma unroll
    for (int j = 0; j < 8; ++j) { const int n = (lane >> 3) + 8 * j; const LAS float* s = scr + n * 65 + 8 * c;
        u32x4 o; o.x = pk2(s[0], s[1]); o.y = pk2(s[2], s[3]); o.z = pk2(s[4], s[5]); o.w = pk2(s[6], s[7]);
        const int dr = permqk ? qk_perm_row(n0 + n) : (n0 + n);
        *(u32x4*)(WT + (size_t)(row_off + dr) * K + k0 + 8 * c) = o; }
    asm volatile("s_waitcnt lgkmcnt(0)" ::: "memory");
}

struct Args { const float* in[17]; float* out; unsigned char* ws; };

__device__ __forceinline__ void p0_phase(const Args& a, int l, LAS unsigned char* lds, int vcu, int G) {
    const int tid = fresh_tid(), lane = tid & 63, wave = __builtin_amdgcn_readfirstlane(tid >> 6);
    LAS float* scr = (LAS float*)(lds + wave * 16640);
    const int gw = vcu * 8 + wave, NGW = G * 8;
    bf16_t* Wb = l ? (bf16_t*)(a.ws + WS_W) : (bf16_t*)((unsigned char*)a.out + DO_W0);
    if (blockIdx.x == 0 && tid < 16) ((unsigned*)a.ws)[64 * tid] = 0u;
    const float* g_mix = a.in[1] + (size_t)l * 1024; const float* w_in = a.in[2] + (size_t)l * 1024 * IN_;
    const float* w_grp = a.in[3] + (size_t)l * 4 * 128 * 128; const float* pscale = a.in[4] + (size_t)l * 512;
    const float* w_bp = a.in[9] + (size_t)l * 512 * 1024; const float* w_ba = a.in[10] + (size_t)l * 1024 * 1024;
    const float* w_gate = a.in[11] + (size_t)l * 1024 * NGATE; const float* w_out = a.in[13] + (size_t)l * 1024 * 1024;
    const float* g_ffn = a.in[14] + (size_t)l * 1024; const float* w_up = a.in[15] + (size_t)l * 1024 * FF; const float* w_down = a.in[16] + (size_t)l * FF * 1024;
    constexpr int I_IN = 16 * (IN_ / 64), I_GATE = 16 * (NGATE / 64), I_BA = 16 * 16, I_OUT = 16 * 16, I_UP = 16 * (FF / 64), I_DOWN = 64 * 16;
    constexpr int NITEMS = I_IN + I_GATE + I_BA + I_OUT + I_UP + I_DOWN;
    for (int it = gw; it < NITEMS; it += NGW) {
        int r = it;
        if (r < I_IN) { transpose_item(w_in, 1024, IN_, Wb + WO_CAT, 0, g_mix, true, scr, r, lane); continue; } r -= I_IN;
        if (r < I_GATE) { transpose_item(w_gate, 1024, NGATE, Wb + WO_CAT, IN_, g_mix, false, scr, r, lane); continue; } r -= I_GATE;
        if (r < I_BA) { transpose_item(w_ba, 1024, 1024, Wb + WO_BA, 0, nullptr, false, scr, r, lane); continue; } r -= I_BA;
        if (r < I_OUT) { transpose_item(w_out, 1024, 1024, Wb + WO_OUT, 0, nullptr, false, scr, r, lane); continue; } r -= I_OUT;
        if (r < I_UP) { transpose_item(w_up, 1024, FF, Wb + WO_UP, 0, g_ffn, false, scr, r, lane); continue; } r -= I_UP;
        transpose_item(w_down, FF, 1024, Wb + WO_DOWN, 0, nullptr, false, scr, r, lane);
    }
    __syncthreads();
    for (int it = vcu; it < 64; it += G) {
        const int g = it >> 4, cb = (it >> 1) & 7, n = (it & 1) * 512 + tid;
        LAS float* wl = (LAS float*)lds;
#pragma unroll
        for (int j = 0; j < 4; ++j) { const int e = tid + 512 * j, cc = e >> 7, d = e & 127; wl[e] = w_grp[((size_t)g * 128 + cb * 16 + cc) * 128 + d] * pscale[g * 128 + d]; }
        __syncthreads();
        const float* bp = w_bp + (size_t)(g * 128) * 1024 + n;
        float acc[16];
#pragma unroll
        for (int cc = 0; cc < 16; ++cc) acc[cc] = 0.f;
#pragma unroll 8
        for (int d = 0; d < 128; ++d) { const float bv = bp[(size_t)d * 1024];
#pragma unroll
            for (int cc = 0; cc < 16; ++cc) acc[cc] += wl[cc * 128 + d] * bv; }
        u32x4 o0, o1;
        o0.x = pk2(acc[0], acc[1]); o0.y = pk2(acc[2], acc[3]); o0.z = pk2(acc[4], acc[5]); o0.w = pk2(acc[6], acc[7]);
        o1.x = pk2(acc[8], acc[9]); o1.y = pk2(acc[10], acc[11]); o1.z = pk2(acc[12], acc[13]); o1.w = pk2(acc[14], acc[15]);
        bf16_t* op = (bf16_t*)(a.ws + (l ? WS_COMB1 : WS_YP)) + (size_t)n * 1024 + g * 128 + cb * 16;
        *(u32x4*)op = o0; *(u32x4*)(op + 8) = o1;
        __syncthreads();
    }
    if (l == 0) {
        const float* x = a.in[0]; bf16_t* xbf = (bf16_t*)(a.ws + WS_XBF); float* RS = (float*)(a.ws + WS_RS);
        for (int m = gw; m < M_; m += NGW) {
            const f32x4* xr = (const f32x4*)(x + (size_t)m * 1024) + lane; f32x4 v[4]; float s = 0.f;
#pragma unroll
            for (int j = 0; j < 4; ++j) { v[j] = xr[64 * j]; const f32x4 q = v[j] * v[j]; s += (q[0] + q[1]) + (q[2] + q[3]); }
            s = wave_sum(s);
            unsigned long long* o8 = (unsigned long long*)(xbf + (size_t)m * QLD) + lane;
#pragma unroll
            for (int j = 0; j < 4; ++j) o8[64 * j] = (unsigned long long)pk2(v[j][0], v[j][1]) | ((unsigned long long)pk2(v[j][2], v[j][3]) << 32);
            if (lane < 16) RS[(size_t)m * 16 + lane] = lane == 0 ? s : 0.f;
        }
    }
}

template <int W> __device__ __forceinline__ void mix_item(const bf16_t* U, bf16_t* YP, int blk, int g, int lane) {
    const int sub = lane >> 4, ch = lane & 15, row0 = blk * 32 + sub * 8, t0 = row0 & (S_ - 1);
    const bf16_t* p = U + (size_t)row0 * ULD + g * 128 + ch * 8;
    u32x4 v[W + 7];
#pragma unroll
    for (int i = 0; i < W + 7; ++i) { const int dt = i - (W - 1); v[i] = (t0 + dt >= 0) ? *(const u32x4*)(p + (ptrdiff_t)dt * ULD) : (u32x4){0u, 0u, 0u, 0u}; }
#pragma unroll
    for (int r = 0; r < 8; ++r) {
        float s0 = 0.f, s1 = 0.f, s2 = 0.f, s3 = 0.f, s4 = 0.f, s5 = 0.f, s6 = 0.f, s7 = 0.f;
#pragma unroll
        for (int j = 0; j < W; ++j) { const u32x4 x = v[r + W - 1 - j];
            s0 += bflo(x.x); s1 += bfhi(x.x); s2 += bflo(x.y); s3 += bfhi(x.y); s4 += bflo(x.z); s5 += bfhi(x.z); s6 += bflo(x.w); s7 += bfhi(x.w); }
        const int t = t0 + r; const float inv = 1.0f / (float)((t + 1 < W) ? (t + 1) : W); const u32x4 self = v[r + W - 1];
        u32x4 o; o.x = pk2(s0 * inv - bflo(self.x), s1 * inv - bfhi(self.x)); o.y = pk2(s2 * inv - bflo(self.y), s3 * inv - bfhi(self.y));
        o.z = pk2(s4 * inv - bflo(self.z), s5 * inv - bfhi(self.z)); o.w = pk2(s6 * inv - bflo(self.w), s7 * inv - bfhi(self.w));
        *(u32x4*)(YP + (size_t)(row0 + r) * QLD + g * 128 + ch * 8) = o;
    }
}
__device__ __forceinline__ void mix_phase(const bf16_t* U, bf16_t* YP, int vcu, int G) {
    const int tid = fresh_tid(), lane = tid & 63, wave = __builtin_amdgcn_readfirstlane(tid >> 6);
    for (int it = vcu * 8 + wave; it < (M_ / 32) * 4; it += G * 8) {
        const int g = it & 3, blk = it >> 2;
        if (g == 0) mix_item<2>(U, YP, blk, 0, lane); else if (g == 1) mix_item<4>(U, YP, blk, 1, lane); else if (g == 2) mix_item<8>(U, YP, blk, 2, lane); else mix_item<16>(U, YP, blk, 3, lane);
    }
}

__device__ __forceinline__ int crow(int r, int hi) { return (r & 3) + 8 * (r >> 2) + 4 * hi; }
__device__ __forceinline__ s16x4 vtr(const LAS unsigned char* p) { return __builtin_bit_cast(s16x4, __builtin_amdgcn_ds_read_tr16_b64_v4i16((LAS v4i16_t*)p)); }
constexpr int AT_STG = 32768, AT_VOF = 16384, AT_WSF = 3 * AT_STG;
static_assert(AT_WSF + 2048 <= 131072 && AT_WSF >= 65536, "attention LDS map");
__device__ __forceinline__ void glds16(const void* gsrc, unsigned lds_dst) { unsigned keep;
    asm volatile("s_mov_b32 %0, m0\n\ts_mov_b32 m0, %2\n\ts_nop 0\n\tglobal_load_lds_dwordx4 %1, off\n\ts_mov_b32 m0, %0" : "=&s"(keep) : "v"(gsrc), "s"(lds_dst) : "memory"); }
#define AT_WAIT_BAR(N) asm volatile("s_waitcnt vmcnt(" #N ") lgkmcnt(0)\n\ts_barrier" ::: "memory")

__device__ __forceinline__ void attn_unit(int b, int h, int qb, const bf16_t* Q, const bf16_t* K, const bf16_t* V, bf16_t* O, const float* gsub, float lam, float oscale, float M2, int kt_lo, LAS unsigned char* lds, int tid, bool do_store = true) {
    const int lane = tid & 63, r32 = lane & 31, hi = lane >> 5, wid = __builtin_amdgcn_readfirstlane(tid >> 6), rg = wid & 3, mp = wid >> 2;
    const size_t rowbase = (size_t)b * S_; const int q0 = qb * 128;
    const bf16_t* Qw = Q + (rowbase + q0 + 32 * rg + r32) * QLD + h * 128 + mp * 64 + hi * 8;
    bf16x8 qr[4];
#pragma unroll
    for (int d0 = 0; d0 < 4; ++d0) qr[d0] = *(const bf16x8*)(Qw + d0 * 16);
    const int NT = 2 * qb + 2, ktmax = 2 * qb + (rg >> 1);
    const float sl2 = __builtin_amdgcn_exp2f(-(float)(h + 1)) * LOG2E;
    const int drow = 8 * wid + (lane >> 4), dch = lane & 15;
    const bf16_t* ks0 = K + (rowbase + (size_t)kt_lo * 64 + drow) * QLD + h * 128 + ((dch ^ (drow & 15)) << 3);
    const bf16_t* ks1 = K + (rowbase + (size_t)kt_lo * 64 + drow + 4) * QLD + h * 128 + ((dch ^ ((drow + 4) & 15)) << 3);
    const bf16_t* vs0 = V + (rowbase + (size_t)kt_lo * 64 + drow) * QLD + h * 128 + ((dch ^ ((drow & 3) << 2)) << 3);
    const bf16_t* vs1 = vs0 + 4 * QLD;
    const unsigned ldsb = (unsigned)(size_t)lds + (unsigned)wid * 2048u;
#define AT_DMA(stage) do { const unsigned d_ = (unsigned)__builtin_amdgcn_readfirstlane((int)(ldsb + (unsigned)(stage) * AT_STG)); \
        glds16(ks0, d_); glds16(ks1, d_ + 1024u); glds16(vs0, d_ + AT_VOF); glds16(vs1, d_ + AT_VOF + 1024u); \
        ks0 += 64 * QLD; ks1 += 64 * QLD; vs0 += 64 * QLD; vs1 += 64 * QLD; } while (0)
    int st_c = 0;
    AT_DMA(0);
    if (kt_lo + 1 < NT) AT_DMA(1);
    asm volatile("" :: "v"(qr[0]), "v"(qr[1]), "v"(qr[2]), "v"(qr[3]));
    f32x16 o[4];
#pragma unroll
    for (int c = 0; c < 4; ++c)
#pragma unroll
        for (int r = 0; r < 16; ++r) o[c][r] = 0.f;
    float l = 0.f;
    int kofs[4], vofs[4];
    { const int q4 = (lane & 15) >> 2, p4 = lane & 3, blk = (lane >> 4) & 1;
#pragma unroll
      for (int d0 = 0; d0 < 4; ++d0) kofs[d0] = r32 * 256 + (((mp * 8 + 2 * d0 + hi) ^ (r32 & 15)) << 4);
#pragma unroll
      for (int c = 0; c < 4; ++c) vofs[c] = AT_VOF + (4 * hi + q4) * 256 + ((((c ^ q4) << 2) | (blk << 1) | (p4 >> 1)) << 4) + 8 * (p4 & 1); }
    const float qposf = (float)(q0 + 32 * rg + r32 - 4 * hi);
    for (int kt = kt_lo; kt < NT; ++kt) {
        if (kt + 1 < NT) AT_WAIT_BAR(4); else AT_WAIT_BAR(0);
        if (kt + 2 < NT) AT_DMA(st_c == 0 ? 2 : st_c - 1);
        if (kt <= ktmax) {
            const LAS unsigned char* sb = lds + st_c * AT_STG;
            f32x16 s0, s1;
#pragma unroll
            for (int r = 0; r < 16; ++r) { s0[r] = -M2; s1[r] = -M2; }
#pragma unroll
            for (int d0 = 0; d0 < 4; ++d0) {
                const bf16x8 a0 = *(const LAS bf16x8*)(sb + kofs[d0]), a1 = *(const LAS bf16x8*)(sb + kofs[d0] + 32 * 256);
                s0 = __builtin_amdgcn_mfma_f32_32x32x16_bf16(a0, qr[d0], s0, 0, 0, 0);
                s1 = __builtin_amdgcn_mfma_f32_32x32x16_bf16(a1, qr[d0], s1, 0, 0, 0);
            }
            s16x4 va[4][2], vc[4][2];
#define AT_VRD(dst, ks) do { _Pragma("unroll") for (int c = 0; c < 4; ++c) { dst[c][0] = vtr(sb + vofs[c] + (ks) * 16 * 256); dst[c][1] = vtr(sb + vofs[c] + (ks) * 16 * 256 + 8 * 256); } } while (0)
#define AT_VMM(src, ks) do { _Pragma("unroll") for (int c = 0; c < 4; ++c) { const bf16x8 vf = (bf16x8){src[c][0][0], src[c][0][1], src[c][0][2], src[c][0][3], src[c][1][0], src[c][1][1], src[c][1][2], src[c][1][3]}; \
                o[c] = __builtin_amdgcn_mfma_f32_32x32x16_bf16(__builtin_bit_cast(bf16x8, pw[ks]), vf, o[c], 0, 0, 0); } } while (0)
            AT_VRD(va, 0);
            __builtin_amdgcn_sched_barrier(0);
            const float dq = qposf - (float)(kt * 64);
            float ls = 0.f;
#pragma unroll
            for (int r = 0; r < 16; ++r) { const float d = dq - (float)((r & 3) + 8 * (r >> 2));
                s0[r] = __builtin_amdgcn_exp2f(__builtin_fmaf(-sl2, __builtin_fabsf(d), s0[r]));
                s1[r] = __builtin_amdgcn_exp2f(__builtin_fmaf(-sl2, __builtin_fabsf(d - 32.0f), s1[r]));
                ls += s0[r] + s1[r]; }
            l += ls;
            u32x4 pw[4];
#pragma unroll
            for (int j = 0; j < 4; ++j) { pw[0][j] = pk2(s0[2 * j], s0[2 * j + 1]); pw[1][j] = pk2(s0[8 + 2 * j], s0[8 + 2 * j + 1]); pw[2][j] = pk2(s1[2 * j], s1[2 * j + 1]); pw[3][j] = pk2(s1[8 + 2 * j], s1[8 + 2 * j + 1]); }
            __builtin_amdgcn_sched_barrier(0);
            AT_VRD(vc, 1); __builtin_amdgcn_sched_barrier(0);
            AT_VMM(va, 0); __builtin_amdgcn_sched_barrier(0);
            AT_VRD(va, 2); __builtin_amdgcn_sched_barrier(0);
            AT_VMM(vc, 1); __builtin_amdgcn_sched_barrier(0);
            AT_VRD(vc, 3); __builtin_amdgcn_sched_barrier(0);
            AT_VMM(va, 2); __builtin_amdgcn_sched_barrier(0);
            AT_VMM(vc, 3); __builtin_amdgcn_sched_barrier(0);
#undef AT_VRD
#undef AT_VMM
        }
        st_c = (st_c == 2) ? 0 : st_c + 1;
    }
    AT_WAIT_BAR(0);
#undef AT_DMA
    l += __shfl_xor(l, 32);
    LAS float* wsf = (LAS float*)(lds + AT_WSF) + wid * 64;
    if (hi == 0) wsf[r32] = l;
    asm volatile("s_waitcnt lgkmcnt(0)" ::: "memory");
#pragma unroll
    for (int r = 0; r < 16; ++r) { const float rl = 1.0f / wsf[crow(r, hi)];
#pragma unroll
        for (int c = 0; c < 4; ++c) o[c][r] *= rl; }
    LAS float* X = (LAS float*)lds + rg * 4096;
    if (mp == 1) {
#pragma unroll
        for (int c = 0; c < 4; ++c)
#pragma unroll
            for (int r = 0; r < 16; ++r) X[crow(r, hi) * 128 + 32 * c + r32] = o[c][r];
    }
    __syncthreads();
    if (mp == 0 && do_store) {
        float gs[4];
#pragma unroll
        for (int c = 0; c < 4; ++c) gs[c] = gsub[32 * c + r32] * oscale;
#pragma unroll
        for (int r = 0; r < 16; ++r) {
            float ss = 0.f;
#pragma unroll
            for (int c = 0; c < 4; ++c) { o[c][r] -= lam * X[crow(r, hi) * 128 + 32 * c + r32]; ss += o[c][r] * o[c][r]; }
            ss += __shfl_xor(ss, 1); ss += __shfl_xor(ss, 2); ss += __shfl_xor(ss, 4); ss += __shfl_xor(ss, 8); ss += __shfl_xor(ss, 16);
            const float rn = rsqrtf(ss * (1.0f / 128.0f) + EPS);
            bf16_t* op = O + (rowbase + q0 + 32 * rg + crow(r, hi)) * QLD + h * 128 + r32;
#pragma unroll
            for (int c = 0; c < 4; ++c) op[32 * c] = (bf16_t)(pk2(o[c][r] * rn * gs[c], 0.f) & 0xffffu);
        }
    }
    __syncthreads();
}

constexpr int AT_ORD = 131072;
constexpr float AT_THR2 = 40.0f;
__device__ __forceinline__ void attn_phase(const Args& a, int l, LAS unsigned char* lds, int bx, int pass = 0, bool do_store = true) {
    const int tid = fresh_tid(), lane = tid & 63;
    const float* gq = a.in[5] + l * 64; const float* gk = a.in[6] + l * 64; const float* lq = a.in[7] + l * 256; const float* gsub = a.in[8] + l * 128;
    const float lambda_init = 0.8f - 0.6f * expf(-0.3f * (float)l);
    const float lam = expf(wave_sum(lq[lane] * lq[64 + lane])) - expf(wave_sum(lq[128 + lane] * lq[192 + lane])) + lambda_init;
    float M2 = 8.0f * wave_max(fabsf(gq[lane])) * wave_max(fabsf(gk[lane])) * LOG2E;
    { const float* nm = (const float*)(a.ws + NM_OFF) + (size_t)l * 8192;
      float mv = 0.f; const int nent = (int)gridDim.x * 16;
      for (int e2 = tid; e2 < nent; e2 += 512) mv = fmaxf(mv, nm[e2]);
      const float wq = wave_max((tid & 1) ? 0.f : mv), wk = wave_max((tid & 1) ? mv : 0.f);
      LAS float* red = (LAS float*)(lds + AT_ORD + 3072);
      if (lane == 0) { red[2 * (tid >> 6)] = wq; red[2 * (tid >> 6) + 1] = wk; }
      __syncthreads();
      float mq = 0.f, mk = 0.f;
#pragma unroll
      for (int w = 0; w < 8; ++w) { mq = fmaxf(mq, red[2 * w]); mk = fmaxf(mk, red[2 * w + 1]); }
      M2 = fminf(M2, sqrtf(mq) * sqrtf(mk) * 1.01f); }
    const bf16_t* Q = (const bf16_t*)(a.ws + WS_Q); const bf16_t* K = (const bf16_t*)(a.ws + WS_K); const bf16_t* V = (const bf16_t*)(a.ws + WS_V);
    LAS int* ord = (LAS int*)(lds + AT_ORD); LAS int* cst = ord + 256; LAS int* cur = cst + 256;
    unsigned* ctr = (unsigned*)a.ws + 512 * pass;
    int my_lo = 0;
    if (tid < 256) {
        const int h = tid >> 5, qb = tid & 31;
        const float sl2 = __builtin_amdgcn_exp2f(-(float)(h + 1)) * LOG2E, Wd = (2.0f * M2 + AT_THR2) / sl2;
        const float x = ((float)(128 * qb - 63) - Wd) * (1.0f / 64.0f);
        my_lo = x > 0.f ? (int)ceilf(x) : 0;
        cst[tid] = ((2 * qb + 2 - my_lo) << 8) | my_lo;
    }
    if (tid < 256) ord[(7 - (tid >> 5)) * 32 + 31 - (tid & 31)] = tid;
    __syncthreads();
    const int xcc = (int)(__builtin_amdgcn_s_getreg((3 << 11) | 20) & 0xFu) & 7;
    for (int qi = 0; qi < 8; ++qi) {
        const int qx = (xcc + qi) & 7;
        for (;;) {
            if (tid == 0) cur[0] = (int)__hip_atomic_fetch_add(ctr + 64 * qx, 1u, __ATOMIC_RELAXED, __HIP_MEMORY_SCOPE_AGENT);
            __syncthreads();
            const int idx = cur[0];
            __syncthreads();
            if (idx >= 256) break;
            const int t = ord[idx], klo = cst[t] & 255;
            attn_unit(qx, t >> 5, t & 31, Q, K, V, (bf16_t*)(a.ws + WS_Q), gsub, lam, 1.0f - lambda_init, M2, klo, lds, tid, do_store);
        }
    }
}

#define XB_TMO      128
#define XB_XCNT(j)  (256  + 64 * (j))
#define XB_XSUB(j)  (1280 + 64 * (j))
#define XB_XGEN(j)  (2304 + 64 * (j))
#define XB_TOP      3328
#define XB_TOPGEN   3392
#define XCD_BAR_WORDS 3456
#define XB_SPIN_CAP (1u << 18)

__device__ __forceinline__ unsigned xb_ld(unsigned* p)              { return __hip_atomic_load(p, __ATOMIC_RELAXED, __HIP_MEMORY_SCOPE_AGENT); }
__device__ __forceinline__ unsigned xb_add(unsigned* p, unsigned v) { return __hip_atomic_fetch_add(p, v, __ATOMIC_RELAXED, __HIP_MEMORY_SCOPE_AGENT); }
__device__ __forceinline__ unsigned xb_xcc_id() { return (unsigned)__builtin_amdgcn_s_getreg((3 << 11) | 20) & 0xFu; }
#define XB_SPIN(cond, bar) do { unsigned _sp = 0; while (cond) { __builtin_amdgcn_s_sleep(1); \
    if ((++_sp & 255u) == 0u) { if (xb_ld(&(bar)[XB_TMO])) break; if (_sp > XB_SPIN_CAP) { atomicAdd(&(bar)[XB_TMO], 1u); break; } } } } while (0)

struct XcdBarrier {
    unsigned* bar; unsigned x;
    volatile __attribute__((address_space(3))) unsigned* st;
};

__device__ __forceinline__ XcdBarrier xcd_barrier_post(unsigned* bar, volatile __attribute__((address_space(3))) unsigned* st) {
    XcdBarrier b; b.bar = bar; b.x = xb_xcc_id(); b.st = st;
    if (threadIdx.x == 0) (void)xb_add(&bar[XB_XCNT(b.x)], 1u);
    return b;
}
__device__ __forceinline__ void xcd_barrier_complete(unsigned* bar, unsigned x, unsigned& nloc, unsigned& nx) {
    const unsigned G = gridDim.x * gridDim.y * gridDim.z;
    unsigned sum, cnt, mine, sp = 0u;
    for (;;) {
        sum = 0u; cnt = 0u; mine = 0u;
#pragma unroll
        for (unsigned j = 0; j < 16; ++j) { const unsigned c = xb_ld(&bar[XB_XCNT(j)]); sum += c; cnt += (c > 0u) ? 1u : 0u; mine = (j == x) ? c : mine; }
        if (sum == G) break;
        __builtin_amdgcn_s_sleep(1);
        if ((++sp & 255u) == 0u) { if (xb_ld(&bar[XB_TMO])) break; if (sp > XB_SPIN_CAP) { atomicAdd(&bar[XB_TMO], 1u); break; } }
    }
    nloc = mine > 0u ? mine : 1u; nx = cnt > 0u ? cnt : 1u;
}

__device__ __forceinline__ void xcd_barrier(const XcdBarrier& b) {
    asm volatile("s_waitcnt vmcnt(0)" ::: "memory");
    __syncthreads();
    if (threadIdx.x == 0) {
        unsigned* bar = b.bar;
        __builtin_amdgcn_s_waitcnt(0);
        unsigned nloc = b.st[0], nx = b.st[1];
        if (nloc == 0u) { xcd_barrier_complete(bar, b.x, nloc, nx); b.st[0] = nloc; b.st[1] = nx; }
        const unsigned old = xb_add(&bar[XB_XSUB(b.x)], 1u);
        const unsigned gen = old / nloc;
        if (old + 1u == (gen + 1u) * nloc) {
            __builtin_amdgcn_fence(__ATOMIC_RELEASE, "agent");
            asm volatile("s_waitcnt vmcnt(0)" ::: "memory");
            const unsigned og = xb_add(&bar[XB_TOP], 1u);
            const unsigned tg = og / nx;
            if (og + 1u == (tg + 1u) * nx) xb_add(&bar[XB_TOPGEN], 1u);
            else XB_SPIN(xb_ld(&bar[XB_TOPGEN]) == tg, bar);
            __builtin_amdgcn_fence(__ATOMIC_ACQUIRE, "agent");
            xb_add(&bar[XB_XGEN(b.x)], 1u);
            asm volatile("s_waitcnt vmcnt(0)" ::: "memory");
        } else {
            XB_SPIN(xb_ld(&bar[XB_XGEN(b.x)]) == gen, bar);
            __builtin_amdgcn_fence(__ATOMIC_ACQUIRE, "agent");
            asm volatile("s_waitcnt vmcnt(0)" ::: "memory");
        }
    }
    __syncthreads();
}

#ifndef STAG_TICKS
#define STAG_TICKS 220
#endif
__device__ __forceinline__ void stagger(int grp) {
    if (grp) { const unsigned long long t0 = __builtin_amdgcn_s_memrealtime(), w = (unsigned long long)grp * STAG_TICKS;
        while (__builtin_amdgcn_s_memrealtime() - t0 < w) __builtin_amdgcn_s_sleep(8); }
}
__global__ void __launch_bounds__(512, 2) fwd(Args a) {
    extern __shared__ __attribute__((aligned(16))) unsigned char lds_raw[];
    LAS unsigned char* lds = (LAS unsigned char*)lds_raw;
    cg::grid_group grid = cg::this_grid();
    const int G = gridDim.x, bx = blockIdx.x, vcu = (G % 8 == 0) ? (bx % 8) * (G / 8) + bx / 8 : bx;
    unsigned char* ws = a.ws;
    bf16_t* Wb; bf16_t* XBF = (bf16_t*)(ws + WS_XBF); float* RS = (float*)(ws + WS_RS);
    bf16_t* Ub = (bf16_t*)(ws + WS_U); bf16_t* Qb = (bf16_t*)(ws + WS_Q); bf16_t* Kb = (bf16_t*)(ws + WS_K); bf16_t* Vb = (bf16_t*)(ws + WS_V);
    bf16_t* Gb = (bf16_t*)(ws + WS_G); bf16_t* YP = (bf16_t*)((unsigned char*)a.out + DO_YP);
    bf16_t* WCOMB;     bf16_t* MRG = (bf16_t*)(ws + WS_MRG); bf16_t* Hb = (bf16_t*)(ws + WS_H);
    unsigned* barw = (unsigned*)ws + 4096;
    volatile LAS unsigned* bst = (volatile LAS unsigned*)(lds + 135168);
    if (threadIdx.x < 2) bst[threadIdx.x] = 0u;
    __syncthreads();
    XcdBarrier xbar = xcd_barrier_post(barw, bst);
    if (a.ws == nullptr) grid.sync();
#define SEAM() xcd_barrier(xbar)
#if PHM & 1
    p0_phase(a, 0, lds, vcu, G);
    p0_phase(a, 1, lds, vcu, G);
#endif
    SEAM();
    for (int l = 0; l < DEPTH; ++l) {
        Wb = l ? (bf16_t*)(ws + WS_W) : (bf16_t*)((unsigned char*)a.out + DO_W0); WCOMB = (bf16_t*)(ws + (l ? WS_COMB1 : WS_YP));
#if PHM & 2
        {
            pg8::Gemm g{XBF, Wb + WO_CAT, M_, NCAT, 1024, 0, QLD}; pg8::StaticOrder S; S.init(M_, NCAT, G, bx, P1_WGM);
            EpiIn E{Ub, Qb, Kb, Vb, Gb, RS, a.in[5] + l * 64, a.in[6] + l * 64, a.in[12] + (size_t)l * NGATE, 0.f, 0.f};
            pg8::gemm_phase<EpiIn, pg8::StaticOrder, true, true>(lds, g, S, E);
            { const float wq = wave_max(E.nq2), wk = wave_max(E.nk2);
              if ((threadIdx.x & 63) == 0) { float* nm = (float*)(ws + NM_OFF) + (size_t)l * 8192 + ((size_t)bx * 8 + (threadIdx.x >> 6)) * 2; nm[0] = wq; nm[1] = wk; } }
#if PROBE_DUP == 2
            SEAM(); pg8::gemm_phase<EpiIn, pg8::StaticOrder, true, true>(lds, g, S, E);
#endif
#if PROBE_DUP == 12
            SEAM(); { EpiNull EN; pg8::gemm_phase<EpiNull, pg8::StaticOrder, true, true>(lds, g, S, EN); }
#endif
        }
#endif
        SEAM();
#if PHM & 4
        mix_phase(Ub, YP, vcu, G);
#if PROBE_DUP == 3
        grid.sync(); mix_phase(Ub, YP, vcu, G);
#endif
#endif
#if PHM & 8
#if PROBE_DUP == 4
        attn_phase(a, l, lds, bx, 1, a.ws == nullptr); grid.sync();
#endif
        attn_phase(a, l, lds, bx, l);
#endif
        SEAM();
#if PHM & 16
        {
            pg8::StaticOrder S; S.init(M_, 1024, G, bx);
            { pg8::Gemm g{YP, WCOMB, M_, 1024, 1024, 512, QLD}; EpiMerge2 E{Gb, MRG}; pg8::gemm_phase2<EpiMerge2, pg8::StaticOrder, true, true>(lds, g, Qb, Wb + WO_BA, 1024, S, E); }
        }
#endif
        SEAM();
#if PHM & 32
        {
            pg8::Gemm g{MRG, Wb + WO_OUT, M_, 1024, 1024, 0, QLD}; pg8::StaticOrder S; S.init(M_, 1024, G, bx);
            EpiResid E{a.out, XBF, RS, 1};
            pg8::gemm_phase<EpiResid, pg8::StaticOrder, true, true>(lds, g, S, E);
        }
        SEAM();
#endif
#if PHM & 64
        {
            pg8::Gemm g{XBF, Wb + WO_UP, M_, FF, 1024, 0, QLD}; pg8::StaticOrder S; S.init(M_, FF, G, bx);
            EpiUp E{Hb, RS};
#if PROBE_DUP == 13
            { pg8::gemm_phase<EpiUp, pg8::StaticOrder, true, true>(lds, g, S, E); SEAM(); }
#elif PROBE_DUP == 14
            { EpiUpT<1> E1{Hb, RS}; pg8::gemm_phase<EpiUpT<1>, pg8::StaticOrder, true, true>(lds, g, S, E1); SEAM(); }
#elif PROBE_DUP == 15
            { EpiNull EN; pg8::gemm_phase<EpiNull, pg8::StaticOrder, true, true>(lds, g, S, EN); SEAM(); }
#endif
            pg8::gemm_phase<EpiUp, pg8::StaticOrder, true, true>(lds, g, S, E);
#if PROBE_DUP == 6
            grid.sync(); pg8::gemm_phase<EpiUp, pg8::StaticOrder, true, true>(lds, g, S, E);
#endif
        }
        SEAM();
#endif
#if PHM & 128
        {
            pg8::Gemm g{Hb, Wb + WO_DOWN, M_, 1024, FF, 0, HLD}; pg8::StaticOrder S; S.init(M_, 1024, G, bx);
            EpiResid E{a.out, XBF, RS, l + 1 < DEPTH ? 1 : 0};
            pg8::gemm_phase<EpiResid, pg8::StaticOrder, true, true>(lds, g, S, E);
        }
#endif
        if (l + 1 < DEPTH) SEAM();
#if PROBE_DUP == 7
        for (int i = 0; i < 10; ++i) SEAM();
#endif
    }
}
}

extern "C" void kernel_launch(void* const* d_in, const int* in_sizes, int n_in, void* d_out, int out_size, void* d_ws, size_t ws_size, hipStream_t stream) {
    static int grid = 0;
    if (grid == 0) {
        if (n_in != 17 || out_size != mk::M_ * mk::D_ || ws_size < mk::WS_END) { fprintf(stderr, "kernel_launch: unexpected shapes (n_in %d, out %d, ws %zu)\n", n_in, out_size, ws_size); grid = -1; return; }
        int dev = 0, cus = 0, per_cu = 0;
        hipGetDevice(&dev);
        hipDeviceGetAttribute(&cus, hipDeviceAttributeMultiprocessorCount, dev);
        if (hipFuncSetAttribute((const void*)mk::fwd, hipFuncAttributeMaxDynamicSharedMemorySize, mk::LDS_BYTES) != hipSuccess) { fprintf(stderr, "kernel_launch: hipFuncSetAttribute failed\n"); grid = -1; return; }
        hipOccupancyMaxActiveBlocksPerMultiprocessor(&per_cu, (const void*)mk::fwd, 512, mk::LDS_BYTES);
        if (per_cu < 1) { fprintf(stderr, "kernel_launch: occupancy query says 0 blocks per CU\n"); per_cu = 1; }
        (void)hipGetLastError();
        grid = cus;
    }
    if (grid < 0) return;
    if (hipMemsetAsync((char*)d_ws + 4096 * 4, 0, XCD_BAR_WORDS * 4, stream) != hipSuccess) { fprintf(stderr, "kernel_launch: hipMemsetAsync of the barrier words failed\n"); return; }
    mk::Args a{};
    for (int i = 0; i < 17; ++i) a.in[i] = (const float*)d_in[i];
    a.out = (float*)d_out; a.ws = (unsigned char*)d_ws;
    void* args[] = {&a};
    hipError_t e = hipLaunchCooperativeKernel((void*)mk::fwd, dim3(grid), dim3(512), args, mk::LDS_BYTES, stream);
    if (e != hipSuccess) fprintf(stderr, "kernel_launch: cooperative launch failed: %s (grid %d)\n", hipGetErrorString(e), grid);
}
```
